# Optimizing an MI355X kernel written in HIP

```python
import jax, jax.numpy as jnp
from jax import lax
import numpy as np

D_MODEL = 1024
BATCH = 4
SEQ = 4096
DEPTH = 1
DEC_BATCH = 16
DEC_SEQ = 2048
PAST_LEN = 128

HEAD_DIM = 64
DIL_PAIRS = ((128, 1), (512, 4), (2048, 16))
HEADS_PER_DIL = 4
N_ATTN_HEADS = HEADS_PER_DIL * len(DIL_PAIRS)
ATTN_WIDTH = N_ATTN_HEADS * HEAD_DIM
N_GMLP_GROUPS = 4
GMLP_GROUP_DIM = 64
GMLP_WIDTH = N_GMLP_GROUPS * GMLP_GROUP_DIM
GMLP_CHUNK = 128
MIX_WIDTH = ATTN_WIDTH + GMLP_WIDTH
IN_WIDTH = 3 * ATTN_WIDTH + 2 * GMLP_WIDTH
D_FF = ((-(-8 * D_MODEL // 3) + 255) // 256) * 256
N_MOD = 6
RMS_EPS = 1e-6
LN_EPS = 1e-5
NEG_INF = -1e30

kernel_name = "hybrid_dilated_attn_gmlp_encoder"


def rms_norm(x, g):
    x32 = x.astype(jnp.float32)
    y = x32 * lax.rsqrt(jnp.mean(x32 * x32, axis=-1, keepdims=True) + RMS_EPS)
    return (y * g.astype(jnp.float32)).astype(x.dtype)


def alibi_slopes():
    return 2.0 ** (-8.0 * jnp.arange(1, N_ATTN_HEADS + 1, dtype=jnp.float32) / N_ATTN_HEADS)


def dilated_window_attention(q, k, v, dil, n_side, slopes):
    B, S, H, E = q.shape
    L = S // dil
    nb = -(-L // n_side)
    Lp = nb * n_side

    def to_classes(t):
        return t.reshape(B, L, dil, H, E).transpose(0, 2, 1, 3, 4)

    qc, kc, vc = to_classes(q), to_classes(k), to_classes(v)
    qb = jnp.pad(qc, ((0, 0), (0, 0), (0, Lp - L), (0, 0), (0, 0))).reshape(B, dil, nb, n_side, H, E)

    def windows(t):
        tp = jnp.pad(t, ((0, 0), (0, 0), (n_side, Lp - L + n_side), (0, 0), (0, 0)))
        tp = tp.reshape(B, dil, nb + 2, n_side, H, E)
        return jnp.concatenate([tp[:, :, :-2], tp[:, :, 1:-1], tp[:, :, 2:]], axis=3)

    kw, vw = windows(kc), windows(vc)
    a = jnp.arange(n_side)
    c = jnp.arange(3 * n_side)
    blk = jnp.arange(nb)
    rel = c[None, :] - n_side - a[:, None]
    key_idx = blk[:, None] * n_side - n_side + c[None, :]
    valid = (jnp.abs(rel)[None] <= n_side) & ((key_idx >= 0) & (key_idx < L))[:, None, :]
    bias = -slopes[:, None, None] * (dil * jnp.abs(rel)).astype(jnp.float32)[None]

    s = jnp.einsum('bdnqhe,bdnkhe->bdnhqk', qb, kw, preferred_element_type=jnp.float32) * (E ** -0.5)
    s = jnp.where(valid[None, None, :, None], s + bias[None, None, None], NEG_INF)
    lse = jax.nn.logsumexp(s, axis=-1)
    p = jnp.exp(s - lse[..., None])
    o = jnp.einsum('bdnhqk,bdnkhe->bdnqhe', p.astype(v.dtype), vw)
    o = o.reshape(B, dil, Lp, H, E)[:, :, :L].transpose(0, 2, 1, 3, 4).reshape(B, S, H, E)
    lse = lse.transpose(0, 1, 2, 4, 3).reshape(B, dil, Lp, H)[:, :, :L].transpose(0, 2, 1, 3).reshape(B, S, H)
    return o, lse


def chunked_spatial_gating(u, v, w_s, b_s, ln_g):
    B, S, _ = u.shape
    u = jax.nn.gelu(u)
    v = jax.nn.gelu(v).reshape(B, S // GMLP_CHUNK, GMLP_CHUNK, N_GMLP_GROUPS, GMLP_GROUP_DIM)
    v32 = v.astype(jnp.float32)
    mu = jnp.mean(v32, axis=-1, keepdims=True)
    var = jnp.mean(jnp.square(v32 - mu), axis=-1, keepdims=True)
    vn = (v32 - mu) * lax.rsqrt(var + LN_EPS) * ln_g.astype(jnp.float32).reshape(N_GMLP_GROUPS, GMLP_GROUP_DIM)
    sv = jnp.einsum('gts,bnsgc->bntgc', w_s.astype(jnp.float32), vn) \
        + b_s.astype(jnp.float32).T[None, None, :, :, None]
    return u * sv.reshape(B, S, GMLP_WIDTH).astype(u.dtype)


def encoder_layer(x, c, w_ada, b_ada, g_pre_mix, w_in, w_s, b_s, g_gmlp, w_out,
                  g_post_mix, g_pre_ffn, w_gu, w_down, g_post_ffn):
    B, S, D = x.shape
    mod = (jnp.dot(jax.nn.silu(c), w_ada) + b_ada)[:, None, :]
    sh1, sc1, gt1, sh2, sc2, gt2 = jnp.split(mod, N_MOD, axis=-1)

    h = rms_norm(x, g_pre_mix) * (1.0 + sc1) + sh1
    proj = jnp.dot(h, w_in)
    A = ATTN_WIDTH
    q = proj[..., :A].reshape(B, S, N_ATTN_HEADS, HEAD_DIM)
    k = proj[..., A:2 * A].reshape(B, S, N_ATTN_HEADS, HEAD_DIM)
    v = proj[..., 2 * A:3 * A].reshape(B, S, N_ATTN_HEADS, HEAD_DIM)
    gu = proj[..., 3 * A:3 * A + GMLP_WIDTH]
    gv = proj[..., 3 * A + GMLP_WIDTH:]

    slopes = alibi_slopes()
    outs, lses = [], []
    for gi, (window, dil) in enumerate(DIL_PAIRS):
        hs = slice(gi * HEADS_PER_DIL, (gi + 1) * HEADS_PER_DIL)
        o, l = dilated_window_attention(q[:, :, hs], k[:, :, hs], v[:, :, hs], dil,
                                        window // (2 * dil), slopes[hs])
        outs.append(o)
        lses.append(l)
    wts = jax.nn.softmax(jnp.stack(lses, axis=0), axis=0)
    attn = jnp.concatenate([(wts[gi][..., None] * outs[gi]).astype(x.dtype) for gi in range(len(DIL_PAIRS))],
                           axis=2).reshape(B, S, ATTN_WIDTH)
    gm = chunked_spatial_gating(gu, gv, w_s, b_s, g_gmlp)
    mix = jnp.dot(jnp.concatenate([attn, gm], axis=-1), w_out)
    x = x + gt1 * rms_norm(mix, g_post_mix)

    h = rms_norm(x, g_pre_ffn) * (1.0 + sc2) + sh2
    gate, up = jnp.split(jnp.dot(h, w_gu), 2, axis=-1)
    f = jnp.dot(jax.nn.silu(gate) * up, w_down)
    return x + gt2 * rms_norm(f, g_post_ffn)


def setup_inputs(seed: int = 0) -> dict:
    key = jax.random.key(seed)
    ks = jax.random.split(key, 18)
    f32 = jnp.float32
    nrm = lambda k, shape, s: jax.random.normal(k, shape, f32) * s
    gain = lambda k, shape: 1.0 + 0.02 * jax.random.normal(k, shape, f32)
    return {
        "x_prompt": jax.random.normal(ks[0], (BATCH, SEQ, D_MODEL), f32),
        "x_sample": jax.random.normal(ks[1], (DEC_BATCH, DEC_SEQ, D_MODEL), f32),
        "c_prompt": jax.random.normal(ks[2], (BATCH, D_MODEL), f32),
        "c_sample": jax.random.normal(ks[3], (DEC_BATCH, D_MODEL), f32),
        "w_ada": nrm(ks[4], (DEPTH, D_MODEL, N_MOD * D_MODEL), 0.5 * D_MODEL ** -0.5),
        "b_ada": nrm(ks[5], (DEPTH, N_MOD * D_MODEL), 0.02),
        "g_pre_mix": gain(ks[6], (DEPTH, D_MODEL)),
        "w_in": nrm(ks[7], (DEPTH, D_MODEL, IN_WIDTH), D_MODEL ** -0.5),
        "w_s": nrm(ks[8], (DEPTH, N_GMLP_GROUPS, GMLP_CHUNK, GMLP_CHUNK), GMLP_CHUNK ** -0.5),
        "b_s": gain(ks[9], (DEPTH, N_GMLP_GROUPS, GMLP_CHUNK)),
        "g_gmlp": gain(ks[10], (DEPTH, GMLP_WIDTH)),
        "w_out": nrm(ks[11], (DEPTH, MIX_WIDTH, D_MODEL), MIX_WIDTH ** -0.5),
        "g_post_mix": gain(ks[12], (DEPTH, D_MODEL)),
        "g_pre_ffn": gain(ks[13], (DEPTH, D_MODEL)),
        "w_gu": nrm(ks[14], (DEPTH, D_MODEL, 2 * D_FF), D_MODEL ** -0.5),
        "w_down": nrm(ks[15], (DEPTH, D_FF, D_MODEL), D_FF ** -0.5),
        "g_post_ffn": gain(ks[16], (DEPTH, D_MODEL)),
    }


def reference(x_prompt, x_sample, c_prompt, c_sample, w_ada, b_ada, g_pre_mix, w_in, w_s, b_s,
              g_gmlp, w_out, g_post_mix, g_pre_ffn, w_gu, w_down, g_post_ffn):
    y_prompt, y_sample = x_prompt, x_sample
    for l in range(DEPTH):
        params = (w_ada[l], b_ada[l], g_pre_mix[l], w_in[l], w_s[l], b_s[l], g_gmlp[l], w_out[l],
                  g_post_mix[l], g_pre_ffn[l], w_gu[l], w_down[l], g_post_ffn[l])
        y_prompt = encoder_layer(y_prompt, c_prompt, *params)
        y_sample = encoder_layer(y_sample, c_sample, *params)
    return (y_prompt, y_sample)
```

```cpp
#include <hip/hip_runtime.h>
#include <hip/hip_cooperative_groups.h>
#include <cstdio>
#include <cstdint>
namespace cg = cooperative_groups;
namespace pg8 {
#define PG8_LAS __attribute__((address_space(3)))
typedef unsigned short bf16_t;
typedef short bf16x8 __attribute__((ext_vector_type(8)));
typedef float f32x4 __attribute__((ext_vector_type(4)));
typedef unsigned u32x4 __attribute__((ext_vector_type(4)));
constexpr int BM = 256, BK = 64, HALF = 128, HTB = HALF * BK * 2  , STAGE_BYTES = 8 * HTB, NXCD = 8, WGM = 8;

__host__ __device__ __forceinline__ int lds_byte(int r, int c) { const int st = (r >> 4) * 2 + (c >> 5), rr = r & 15, cc = c & 31, ob = rr * 64 + cc * 2; return st * 1024 + (ob ^ (((ob >> 9) & 1) << 5)); }
__host__ __device__ __forceinline__ void stage_rc(int b, int& R, int& C) { const int st = b / 1024, sb = b % 1024, swz = sb ^ (((sb >> 9) & 1) << 5); R = (st >> 1) * 16 + swz / 64; C = (st & 1) * 32 + (swz % 64) / 2; }
__host__ __device__ __forceinline__ int perm32(int rho) { const int n = rho >> 4, i = rho & 15; return 8 * (i >> 2) + 4 * n + (i & 3); }

struct Unit { int pm, pn; };
struct Gemm { const bf16_t* A; const bf16_t* Bt; int M, N, K; };

struct StaticOrder {
    int nM, nN, nwg, G, c;
    __host__ __device__ void init(int M, int N, int G_, int c_) { nM = M / BM; nN = N / BM; nwg = nM * nN; G = G_; c = c_; }
    __host__ __device__ bool next(int i, Unit& u) const {
        const long L = (long)i * G + c; if (L >= nwg) return false;
        int wgid = (int)L; { const int q = nwg / NXCD, r = nwg % NXCD, xcd = wgid % NXCD, off = wgid / NXCD; wgid = (xcd < r ? xcd * (q + 1) : r * (q + 1) + (xcd - r) * q) + off; }
        const int nig = WGM * nN, gid = wgid / nig, fm = gid * WGM, gsz = (nM - fm) < WGM ? (nM - fm) : WGM;
        u.pm = fm + ((wgid % nig) % gsz); u.pn = (wgid % nig) / gsz; return true;
    }
    __device__ __forceinline__ void a_ready(const Unit&) const {}
    __device__ __forceinline__ void done(const Unit&) const {}
};

__device__ __forceinline__ unsigned cvt_pk_bf16(float lo, float hi) { unsigned r; asm volatile("v_cvt_pk_bf16_f32 %0, %1, %2" : "=v"(r) : "v"(lo), "v"(hi)); return r; }
typedef float f32x2 __attribute__((ext_vector_type(2)));
struct EpiStore {
    static constexpr bool PERM = true, AFTER_DRAIN = false;
    bf16_t* O; int ldc;
    __device__ __forceinline__ void operator()(const f32x4 (&acc)[2][2][4][2], const Unit& u, int wr, int wc, int fr, int fq) const {
        const int row0 = u.pm * BM + wr * 64 + fr; const int col0 = u.pn * BM + wc * 32 + 8 * fq;
#pragma unroll
        for (int ai = 0; ai < 2; ++ai)
#pragma unroll
            for (int m = 0; m < 4; ++m) { bf16_t* rowp = O + (size_t)(row0 + ai * HALF + m * 16) * ldc + col0;
#pragma unroll
                for (int bj = 0; bj < 2; ++bj) { const f32x4 v0 = acc[ai][bj][m][0], v1 = acc[ai][bj][m][1];
                    u32x4 w; w.x = cvt_pk_bf16(v0[0], v0[1]); w.y = cvt_pk_bf16(v0[2], v0[3]); w.z = cvt_pk_bf16(v1[0], v1[1]); w.w = cvt_pk_bf16(v1[2], v1[3]);
                    *(u32x4*)(rowp + bj * HALF) = w; } }
    }
};
__device__ __forceinline__ float silu_f(float g) { return g * __builtin_amdgcn_rcpf(1.0f + __builtin_amdgcn_exp2f(-1.44269504089f * g)); }
struct EpiSwiGLU {
    static constexpr bool PERM = true, AFTER_DRAIN = false;
    bf16_t* O; int ldc;
    __device__ __forceinline__ void operator()(const f32x4 (&acc)[2][2][4][2], const Unit& u, int wr, int wc, int fr, int fq) const {
        const int row0 = u.pm * BM + wr * 64 + fr; const int col0 = u.pn * HALF + wc * 32 + 8 * fq;
#pragma unroll
        for (int ai = 0; ai < 2; ++ai)
#pragma unroll
            for (int m = 0; m < 4; ++m) { bf16_t* rowp = O + (size_t)(row0 + ai * HALF + m * 16) * ldc + col0;
                const f32x4 g0 = acc[ai][0][m][0], g1 = acc[ai][0][m][1], u0 = acc[ai][1][m][0], u1 = acc[ai][1][m][1];
                u32x4 w;
                w.x = cvt_pk_bf16(silu_f(g0[0]) * u0[0], silu_f(g0[1]) * u0[1]); w.y = cvt_pk_bf16(silu_f(g0[2]) * u0[2], silu_f(g0[3]) * u0[3]);
                w.z = cvt_pk_bf16(silu_f(g1[0]) * u1[0], silu_f(g1[1]) * u1[1]); w.w = cvt_pk_bf16(silu_f(g1[2]) * u1[2], silu_f(g1[3]) * u1[3]);
                *(u32x4*)rowp = w; }
    }
};
template <class Epi, class Sched, bool ALIGN_EPI = false, bool SP2 = false>
__device__ __forceinline__ void gemm_phase(PG8_LAS unsigned char* lds, const Gemm g, const Sched& S, const Epi& E) {
    const int tid = threadIdx.x, wid = __builtin_amdgcn_readfirstlane(tid >> 6), lane = tid & 63, wr = wid >> 2, wc = wid & 3, fr = lane & 15, fq = lane >> 4;
    const int K = g.K, nt = K / BK;
    unsigned voffA[2], voffB[2];
#pragma unroll
    for (int i = 0; i < 2; ++i) { int R, C; stage_rc(tid * 16 + i * 8192, R, C); const int Rb = Epi::PERM ? ((R & ~31) + perm32(R & 31)) : R;
        voffA[i] = (unsigned)(R * K + C) * 2u; voffB[i] = (unsigned)(Rb * K + C) * 2u; }
    const size_t kstep = (size_t)(BK * 2);
    const size_t hstep = (size_t)HALF * K * 2;
    const size_t tstep = 2 * hstep;
    const unsigned ldsw = (unsigned)wid * 1024u;
    const int aoff = lds_byte(wr * 64 + fr, fq * 8), boff = lds_byte(wc * 32 + fr, fq * 8);
#define PG8_SA(b, h) (((b) * 2 + (h)) * HTB)
#define PG8_SB(b, h) ((4 + (b) * 2 + (h)) * HTB)
#define PG8_STAGE(bufoff, gbase, voff) do { _Pragma("unroll") for (int _i = 0; _i < 2; ++_i) \
        __builtin_amdgcn_global_load_lds((const unsigned*)((const char*)(gbase) + (voff)[_i]), (PG8_LAS unsigned*)(lds + (bufoff) + ldsw + _i * 8192), 16, 0, 0); } while (0)
#define PG8_LDA(dst, b, h) do { _Pragma("unroll") for (int m = 0; m < 4; ++m) _Pragma("unroll") for (int k = 0; k < 2; ++k) dst[m][k] = *(const PG8_LAS bf16x8*)(lds + PG8_SA(b, h) + aoff + m * 2048 + k * 1024); } while (0)
#define PG8_LDB(dst, b, h) do { _Pragma("unroll") for (int n = 0; n < 2; ++n) _Pragma("unroll") for (int k = 0; k < 2; ++k) dst[n][k] = *(const PG8_LAS bf16x8*)(lds + PG8_SB(b, h) + boff + n * 2048 + k * 1024); } while (0)
#define PG8_MMA(ai, bj, At, Bt) do { __builtin_amdgcn_s_setprio(1); _Pragma("unroll") for (int m = 0; m < 4; ++m) _Pragma("unroll") for (int n = 0; n < 2; ++n) _Pragma("unroll") for (int k = 0; k < 2; ++k) \
        acc[ai][bj][m][n] = __builtin_amdgcn_mfma_f32_16x16x32_bf16(Bt[n][k], At[m][k], acc[ai][bj][m][n], 0, 0, 0); __builtin_amdgcn_s_setprio(0); } while (0)
#define PG8_WAIT_V(n) asm volatile("s_waitcnt vmcnt(" #n ")" ::: "memory")
#define PG8_WAIT_L(n) asm volatile("s_waitcnt lgkmcnt(" #n ")" ::: "memory")
#define PG8_BAR __builtin_amdgcn_s_barrier()
#define PG8_SCHED __builtin_amdgcn_sched_barrier(0)
    Unit cur, nxt; int ui = 0;
    if (!S.next(0, cur)) return;
    f32x4 acc[2][2][4][2];
#pragma unroll
    for (int a = 0; a < 2; ++a)
#pragma unroll
        for (int b = 0; b < 2; ++b)
#pragma unroll
            for (int m = 0; m < 4; ++m)
#pragma unroll
                for (int n = 0; n < 2; ++n) acc[a][b][m][n] = (f32x4){0.f, 0.f, 0.f, 0.f};
    bf16x8 At[4][2], B0[2][2], B1[2][2];
    const char* cA = (const char*)g.A + (size_t)cur.pm * tstep; const char* cB = (const char*)g.Bt + (size_t)cur.pn * tstep;
    S.a_ready(cur);
    if constexpr (SP2) {
        PG8_STAGE(PG8_SB(0, 0), cB, voffB); PG8_STAGE(PG8_SB(0, 1), cB + hstep, voffB); PG8_STAGE(PG8_SA(0, 0), cA, voffA); PG8_STAGE(PG8_SA(0, 1), cA + hstep, voffA);
        if (wr == 1) PG8_BAR;
        PG8_WAIT_V(2); PG8_BAR;
        PG8_STAGE(PG8_SB(1, 0), cB + kstep, voffB); PG8_STAGE(PG8_SA(1, 0), cA + kstep, voffA); PG8_STAGE(PG8_SB(1, 1), cB + hstep + kstep, voffB);
        PG8_WAIT_V(6); PG8_BAR;
    } else {
        PG8_STAGE(PG8_SB(0, 0), cB, voffB); PG8_STAGE(PG8_SA(0, 0), cA, voffA); PG8_STAGE(PG8_SB(0, 1), cB + hstep, voffB); PG8_STAGE(PG8_SA(0, 1), cA + hstep, voffA);
        if (wr == 1) PG8_BAR;
        PG8_WAIT_V(4); PG8_BAR;
        PG8_STAGE(PG8_SB(1, 0), cB + kstep, voffB); PG8_STAGE(PG8_SA(1, 0), cA + kstep, voffA); PG8_STAGE(PG8_SB(1, 1), cB + hstep + kstep, voffB);
        PG8_WAIT_V(6); PG8_BAR;
    }
    for (;;) {
        const bool has_next = S.next(ui + 1, nxt);
        const char* nA = has_next ? (const char*)g.A + (size_t)nxt.pm * tstep : cA; const char* nB = has_next ? (const char*)g.Bt + (size_t)nxt.pn * tstep : cB;
        for (int t = 0; t < nt; t += 2) {
            const bool last = (t == nt - 2);
            const char* a1 = cA + (size_t)(t + 1) * kstep;
            const char* a2 = last ? nA : cA + (size_t)(t + 2) * kstep; const char* b2 = last ? nB : cB + (size_t)(t + 2) * kstep;
            const char* a3 = a2 + kstep; const char* b3 = b2 + kstep;
            if (last && has_next) S.a_ready(nxt);
            if constexpr (SP2) {
            PG8_LDB(B0, 0, 0); PG8_LDB(B1, 0, 1); PG8_SCHED; PG8_LDA(At, 0, 0); PG8_STAGE(PG8_SA(1, 1), a1 + hstep, voffA);
            PG8_WAIT_V(8); PG8_WAIT_L(0); PG8_BAR; PG8_MMA(0, 0, At, B0); PG8_MMA(0, 1, At, B1); PG8_BAR; PG8_SCHED;
            PG8_LDA(At, 0, 1); PG8_STAGE(PG8_SB(0, 0), b2, voffB); PG8_STAGE(PG8_SB(0, 1), b2 + hstep, voffB); PG8_STAGE(PG8_SA(0, 0), a2, voffA);
            PG8_WAIT_V(8); PG8_WAIT_L(0); PG8_BAR; PG8_MMA(1, 0, At, B0); PG8_MMA(1, 1, At, B1); PG8_BAR; PG8_SCHED;
            PG8_LDB(B0, 1, 0); PG8_LDB(B1, 1, 1); PG8_SCHED; PG8_LDA(At, 1, 0); PG8_STAGE(PG8_SA(0, 1), a2 + hstep, voffA);
            PG8_WAIT_V(8); PG8_WAIT_L(0); PG8_BAR; PG8_MMA(0, 0, At, B0); PG8_MMA(0, 1, At, B1); PG8_BAR; PG8_SCHED;
            PG8_LDA(At, 1, 1); PG8_STAGE(PG8_SB(1, 0), b3, voffB); PG8_STAGE(PG8_SB(1, 1), b3 + hstep, voffB); PG8_STAGE(PG8_SA(1, 0), a3, voffA);
            PG8_WAIT_V(8); PG8_WAIT_L(0); PG8_BAR; PG8_MMA(1, 0, At, B0); PG8_MMA(1, 1, At, B1); PG8_BAR; PG8_SCHED;
            } else {
            PG8_LDB(B0, 0, 0); PG8_SCHED; PG8_LDA(At, 0, 0); PG8_STAGE(PG8_SA(1, 1), a1 + hstep, voffA);
            PG8_WAIT_L(8); PG8_BAR; PG8_WAIT_L(0); PG8_MMA(0, 0, At, B0); PG8_BAR; PG8_SCHED;
            PG8_LDB(B1, 0, 1); PG8_STAGE(PG8_SB(0, 0), b2, voffB);
            PG8_BAR; PG8_WAIT_L(0); PG8_MMA(0, 1, At, B1); PG8_BAR;
            PG8_LDA(At, 0, 1); PG8_STAGE(PG8_SA(0, 0), a2, voffA);
            PG8_BAR; PG8_WAIT_L(0); PG8_MMA(1, 0, At, B0); PG8_BAR; PG8_SCHED;
            PG8_STAGE(PG8_SB(0, 1), b2 + hstep, voffB);
            PG8_WAIT_V(6); PG8_BAR; PG8_MMA(1, 1, At, B1); PG8_BAR;
            PG8_LDB(B0, 1, 0); PG8_SCHED; PG8_LDA(At, 1, 0); PG8_STAGE(PG8_SA(0, 1), a2 + hstep, voffA);
            PG8_WAIT_L(8); PG8_BAR; PG8_WAIT_L(0); PG8_MMA(0, 0, At, B0); PG8_BAR; PG8_SCHED;
            PG8_LDB(B1, 1, 1); PG8_STAGE(PG8_SB(1, 0), b3, voffB);
            PG8_BAR; PG8_WAIT_L(0); PG8_MMA(0, 1, At, B1); PG8_BAR;
            PG8_LDA(At, 1, 1); PG8_STAGE(PG8_SA(1, 0), a3, voffA);
            PG8_BAR; PG8_WAIT_L(0); PG8_MMA(1, 0, At, B0); PG8_BAR; PG8_SCHED;
            PG8_STAGE(PG8_SB(1, 1), b3 + hstep, voffB);
            PG8_WAIT_V(6); PG8_BAR; PG8_MMA(1, 1, At, B1); PG8_BAR;
            }
        }
        if constexpr (ALIGN_EPI) { if (wr == 0) PG8_BAR; }
        if constexpr (!Epi::AFTER_DRAIN) { E(acc, cur, wr, wc, fr, fq); S.done(cur); }
        if (!has_next) break;
#pragma unroll
        for (int a = 0; a < 2; ++a)
#pragma unroll
            for (int b = 0; b < 2; ++b)
#pragma unroll
                for (int m = 0; m < 4; ++m)
#pragma unroll
                    for (int n = 0; n < 2; ++n) acc[a][b][m][n] = (f32x4){0.f, 0.f, 0.f, 0.f};
        cur = nxt; cA = nA; cB = nB; ++ui;
        if constexpr (ALIGN_EPI) { if (wr == 1) PG8_BAR; }
    }
    PG8_WAIT_V(0);
    if constexpr (!ALIGN_EPI) { if (wr == 0) PG8_BAR; }
    PG8_BAR;
    if constexpr (Epi::AFTER_DRAIN) { E.fused(acc, cur, wr, wc, fr, fq, lds, wid, lane); S.done(cur); }
#undef PG8_SA
#undef PG8_SB
#undef PG8_STAGE
#undef PG8_LDA
#undef PG8_LDB
#undef PG8_MMA
#undef PG8_WAIT_V
#undef PG8_WAIT_L
#undef PG8_BAR
#undef PG8_SCHED
}
}

constexpr int D = 1024, NPB = 4, PSEQ = 4096, NSB = 16, SSEQ = 2048, NB = NPB + NSB;
constexpr int MP = NPB * PSEQ;
constexpr int M = MP + NSB * SSEQ;
constexpr int NIN = 2816, NFF = 2816, NMOD = 6 * D;
constexpr int QOFF = 0, KOFF = 768, VOFF = 1536, GUOFF = 2304, GVOFF = 2560;
constexpr float RMS_EPS = 1e-6f, LN_EPS = 1e-5f, LOG2E = 1.44269504089f, LN2 = 0.69314718056f;
constexpr size_t MiB = 1u << 20;
constexpr size_t WS_MOD = 0;
constexpr size_t WS_WIN = 1 * MiB, WS_WOUT = 7 * MiB, WS_WGU = 9 * MiB, WS_WDN = 20 * MiB, WS_WSB = 26 * MiB;
constexpr size_t WS_LSE = 27 * MiB;
constexpr size_t WS_XN = 30 * MiB;
constexpr size_t WS_CAT = 126 * MiB;
constexpr size_t WS_PROJ = 222 * MiB;
constexpr size_t WS_END = 486 * MiB;
constexpr int LDS_BYTES = 147456;

#define LAS __attribute__((address_space(3)))
typedef unsigned short bf16_t;
typedef short bf16x8 __attribute__((ext_vector_type(8)));
typedef short s16x4 __attribute__((ext_vector_type(4)));
typedef short v4i16_t __attribute__((ext_vector_type(4)));
typedef float f32x4 __attribute__((ext_vector_type(4)));
typedef float f32x16 __attribute__((ext_vector_type(16)));
typedef unsigned u32x4 __attribute__((ext_vector_type(4)));
typedef unsigned u32x2 __attribute__((ext_vector_type(2)));
#define LDS_WAIT() asm volatile("s_waitcnt lgkmcnt(0)" ::: "memory")
#define MFMA32(a, b, c) __builtin_amdgcn_mfma_f32_32x32x16_bf16((a), (b), (c), 0, 0, 0)

struct Params {
    const float *x_prompt, *x_sample, *c_prompt, *c_sample, *w_ada, *b_ada, *g_pre_mix, *w_in, *w_s, *b_s, *g_gmlp, *w_out, *g_post_mix, *g_pre_ffn, *w_gu, *w_down, *g_post_ffn;
    float* out; unsigned char* ws; int ph_lo, ph_hi;
};

__device__ __forceinline__ unsigned pk2(float lo, float hi) { return pg8::cvt_pk_bf16(lo, hi); }
__device__ __forceinline__ float bf2f(short v) { return __uint_as_float(((unsigned)(unsigned short)v) << 16); }
__device__ __forceinline__ float bflo(unsigned w) { return __uint_as_float(w << 16); }
__device__ __forceinline__ float bfhi(unsigned w) { return __uint_as_float(w & 0xffff0000u); }
__device__ __forceinline__ float wave_sum(float v) {
#pragma unroll
    for (int o = 1; o < 64; o <<= 1) v += __shfl_xor(v, o);
    return v;
}
__device__ __forceinline__ float gelu_tanh(float x) {
    const float y = 0.7978845608f * (x + 0.044715f * x * x * x);
    return x * __builtin_amdgcn_rcpf(1.0f + __builtin_amdgcn_exp2f(-2.0f * LOG2E * y));
}
__device__ __forceinline__ int crow(int i, int h) { return (i & 3) + 8 * (i >> 2) + 4 * h; }
__device__ __forceinline__ const float* xrow_ptr(const Params& p, int m) { return m < MP ? p.x_prompt + (size_t)m * D : p.x_sample + (size_t)(m - MP) * D; }
__device__ __forceinline__ int batch_of(int m) { return m < MP ? (m >> 12) : NPB + ((m - MP) >> 11); }

__device__ __forceinline__ void transpose_item(const float* W, int K, int N, bf16_t* WT, int k0, int n0, int drow0, LAS float* scr, int lane) {
#pragma unroll 8
    for (int i = 0; i < 32; ++i) { const int kk = 2 * i + (lane >> 5); scr[kk * 33 + (lane & 31)] = W[(size_t)(k0 + kk) * N + n0 + (lane & 31)]; }
    LDS_WAIT();
    const int c = lane & 7;
#pragma unroll
    for (int j = 0; j < 4; ++j) { const int n = (lane >> 3) + 8 * j; const LAS float* s = scr + (8 * c) * 33 + n;
        u32x4 o; o.x = pk2(s[0 * 33], s[1 * 33]); o.y = pk2(s[2 * 33], s[3 * 33]); o.z = pk2(s[4 * 33], s[5 * 33]); o.w = pk2(s[6 * 33], s[7 * 33]);
        *(u32x4*)(WT + (size_t)(drow0 + n) * K + k0 + 8 * c) = o; }
    LDS_WAIT();
}
__device__ __forceinline__ void phase0(const Params& p, LAS unsigned char* lds, int tid, int wave, int lane) {
    unsigned char* ws = p.ws;
    const int G = gridDim.x;
    if (blockIdx.x < 192) {
        LAS float* sc = (LAS float*)lds;
        LAS float* red = (LAS float*)(lds + 81920);
        float* mod = (float*)(ws + WS_MOD);
        for (int idx = tid; idx < NB * D; idx += 512) { const int b = idx >> 10, k = idx & 1023;
            const float c = b < NPB ? p.c_prompt[b * D + k] : p.c_sample[(b - NPB) * D + k];
            sc[k * NB + b] = c / (1.0f + __expf(-c)); }
        __syncthreads();
        for (int item = blockIdx.x; item < 192; item += G) {
            const int col = 32 * item + (lane & 31);
            float acc[NB];
#pragma unroll
            for (int b = 0; b < NB; ++b) acc[b] = 0.f;
            const int k0 = wave * 128 + (lane >> 5);
#pragma unroll 8
            for (int it = 0; it < 64; ++it) { const int k = k0 + 2 * it; const float w = p.w_ada[(size_t)k * NMOD + col];
                const LAS f32x4* s4 = (const LAS f32x4*)(sc + k * NB);
#pragma unroll
                for (int q = 0; q < 5; ++q) { const f32x4 s = s4[q]; acc[4 * q] += w * s[0]; acc[4 * q + 1] += w * s[1]; acc[4 * q + 2] += w * s[2]; acc[4 * q + 3] += w * s[3]; } }
#pragma unroll
            for (int b = 0; b < NB; ++b) acc[b] += __shfl_xor(acc[b], 32);
            if (lane < 32) {
#pragma unroll
                for (int b = 0; b < NB; ++b) red[(wave * NB + b) * 32 + lane] = acc[b]; }
            __syncthreads();
            for (int idx = tid; idx < NB * 32; idx += 512) { const int b = idx >> 5, c = idx & 31; float s = 0.f;
#pragma unroll
                for (int w = 0; w < 8; ++w) s += red[(w * NB + b) * 32 + c];
                mod[b * NMOD + 32 * item + c] = s + p.b_ada[32 * item + c]; }
            __syncthreads();
        }
    }
    __syncthreads();
    const int gw = blockIdx.x * 8 + wave, NGW = G * 8;
    LAS float* scr = (LAS float*)(lds + wave * 16384);
    constexpr int I_IN = 16 * 88, I_OUT = 16 * 32, I_GU = 16 * 176, I_DN = 44 * 32, NITEMS = I_IN + I_OUT + I_GU + I_DN;
    for (int it = gw; it < NITEMS; it += NGW) {
        int r = it;
        if (r < I_IN) { const int kb = r / 88, nb = r % 88; transpose_item(p.w_in, D, NIN, (bf16_t*)(ws + WS_WIN), 64 * kb, 32 * nb, 32 * nb, scr, lane); continue; } r -= I_IN;
        if (r < I_OUT) { const int kb = r / 32, nb = r % 32; transpose_item(p.w_out, D, D, (bf16_t*)(ws + WS_WOUT), 64 * kb, 32 * nb, 32 * nb, scr, lane); continue; } r -= I_OUT;
        if (r < I_GU) { const int kb = r / 176, nb = r % 176; const int n0 = 32 * nb; const int up = n0 >= NFF ? 1 : 0; const int j0 = n0 - up * NFF;
            const int drow0 = (j0 >> 7) * 256 + up * 128 + (j0 & 127);
            transpose_item(p.w_gu, D, 2 * NFF, (bf16_t*)(ws + WS_WGU), 64 * kb, n0, drow0, scr, lane); continue; } r -= I_GU;
        { const int kb = r / 32, nb = r % 32; transpose_item(p.w_down, NFF, D, (bf16_t*)(ws + WS_WDN), 64 * kb, 32 * nb, 32 * nb, scr, lane); }
    }
    for (int i = blockIdx.x * 512 + tid; i < 4 * 128 * 128 / 8; i += G * 512) {
        const f32x4 a = ((const f32x4*)p.w_s)[2 * i], b = ((const f32x4*)p.w_s)[2 * i + 1];
        u32x4 o; o.x = pk2(a[0], a[1]); o.y = pk2(a[2], a[3]); o.z = pk2(b[0], b[1]); o.w = pk2(b[2], b[3]);
        ((u32x4*)(ws + WS_WSB))[i] = o; }
}

__device__ __forceinline__ void phase1(const Params& p, int wave, int lane) {
    const float* mod = (const float*)(p.ws + WS_MOD); bf16_t* XN = (bf16_t*)(p.ws + WS_XN);
    const int gw = blockIdx.x * 8 + wave, NGW = gridDim.x * 8;
    for (int item = gw; item < M / 8; item += NGW) {
        const int m0 = item * 8; const float* mb = mod + batch_of(m0) * NMOD;
        f32x4 gs[4], sh[4];
#pragma unroll
        for (int j = 0; j < 4; ++j) { const f32x4 g = ((const f32x4*)p.g_pre_mix)[lane + 64 * j], s = ((const f32x4*)(mb + D))[lane + 64 * j];
            gs[j] = g * (1.0f + s); sh[j] = ((const f32x4*)mb)[lane + 64 * j]; }
        for (int r = 0; r < 8; ++r) { const int m = m0 + r; const f32x4* xr = (const f32x4*)xrow_ptr(p, m) + lane;
            f32x4 v[4]; float ss = 0.f;
#pragma unroll
            for (int j = 0; j < 4; ++j) { v[j] = xr[64 * j]; ss += (v[j][0] * v[j][0] + v[j][1] * v[j][1]) + (v[j][2] * v[j][2] + v[j][3] * v[j][3]); }
            const float rstd = rsqrtf(wave_sum(ss) * (1.0f / D) + RMS_EPS);
            u32x2* o8 = (u32x2*)(XN + (size_t)m * D) + lane;
#pragma unroll
            for (int j = 0; j < 4; ++j) { const f32x4 h = v[j] * rstd * gs[j] + sh[j]; u32x2 w; w.x = pk2(h[0], h[1]); w.y = pk2(h[2], h[3]); o8[64 * j] = w; }
        }
    }
}

constexpr int G_SP = 272, G_IMG = 64 * G_SP;
__device__ __forceinline__ void gmlp_item(const Params& p, int n, LAS unsigned char* lds, int wave, int lane) {
    const bf16_t* PROJ = (const bf16_t*)(p.ws + WS_PROJ); bf16_t* CAT = (bf16_t*)(p.ws + WS_CAT); const bf16_t* WSB = (const bf16_t*)(p.ws + WS_WSB);
    const int m0 = n * 128, g = wave >> 1, r32 = lane & 31, h = lane >> 5;
    {
        const int pos = (wave & 1) * 64 + lane;
        const bf16_t* vp = PROJ + (size_t)(m0 + pos) * NIN + GVOFF + g * 64;
        float v[64]; float s = 0.f;
#pragma unroll
        for (int c8 = 0; c8 < 8; ++c8) { const bf16x8 raw = *(const bf16x8*)(vp + 8 * c8);
#pragma unroll
            for (int e = 0; e < 8; ++e) { const float t = gelu_tanh(bf2f(raw[e])); v[8 * c8 + e] = t; s += t; } }
        const float mu = s * (1.0f / 64.0f); float q = 0.f;
#pragma unroll
        for (int c = 0; c < 64; ++c) { const float d = v[c] - mu; q += d * d; }
        const float rstd = rsqrtf(q * (1.0f / 64.0f) + LN_EPS);
        LAS unsigned char* img = lds + g * G_IMG + pos * 2;
#pragma unroll
        for (int c = 0; c < 64; c += 2) { const unsigned w = pk2((v[c] - mu) * rstd * p.g_gmlp[g * 64 + c], (v[c + 1] - mu) * rstd * p.g_gmlp[g * 64 + c + 1]);
            *(LAS unsigned short*)(img + c * G_SP) = (unsigned short)(w & 0xffffu); *(LAS unsigned short*)(img + (c + 1) * G_SP) = (unsigned short)(w >> 16); }
    }
    __syncthreads();
    {
        const int th = wave & 1;
        f32x16 acc[2][2];
#pragma unroll
        for (int a = 0; a < 2; ++a)
#pragma unroll
            for (int b = 0; b < 2; ++b)
#pragma unroll
                for (int i = 0; i < 16; ++i) acc[a][b][i] = 0.f;
        const bf16_t* wrow = WSB + (size_t)(g * 128 + 64 * th + r32) * 128 + 8 * h;
        const LAS unsigned char* brow = lds + g * G_IMG + r32 * G_SP + 16 * h;
#pragma unroll
        for (int ks = 0; ks < 8; ++ks) {
            bf16x8 a[2], b[2];
#pragma unroll
            for (int tb = 0; tb < 2; ++tb) a[tb] = *(const bf16x8*)(wrow + (size_t)(32 * tb) * 128 + 16 * ks);
#pragma unroll
            for (int cb = 0; cb < 2; ++cb) b[cb] = *(const LAS bf16x8*)(brow + (32 * cb) * G_SP + 32 * ks);
#pragma unroll
            for (int tb = 0; tb < 2; ++tb)
#pragma unroll
                for (int cb = 0; cb < 2; ++cb) acc[tb][cb] = MFMA32(a[tb], b[cb], acc[tb][cb]);
        }
#pragma unroll
        for (int tb = 0; tb < 2; ++tb)
#pragma unroll
            for (int i = 0; i < 16; ++i) { const int t = 64 * th + 32 * tb + crow(i, h); const float bias = p.b_s[g * 128 + t];
                const bf16_t* up = PROJ + (size_t)(m0 + t) * NIN + GUOFF + g * 64 + r32; bf16_t* op = CAT + (size_t)(m0 + t) * D + 768 + g * 64 + r32;
#pragma unroll
                for (int cb = 0; cb < 2; ++cb) { const float u = gelu_tanh(bf2f((short)up[32 * cb])); op[32 * cb] = (bf16_t)(pk2(u * (acc[tb][cb][i] + bias), 0.f) & 0xffffu); } }
    }
    __syncthreads();
}

constexpr int V_SP = 144, V_BUF = 32 * V_SP;
__device__ __forceinline__ s16x4 vtr(const LAS unsigned char* q) { return __builtin_bit_cast(s16x4, __builtin_amdgcn_ds_read_tr16_b64_v4i16((LAS v4i16_t*)q)); }
__device__ __forceinline__ void attn_tile(const Params& p, int id, LAS unsigned char* vbuf, int lane) {
    const bf16_t* PROJ = (const bf16_t*)(p.ws + WS_PROJ); bf16_t* CAT = (bf16_t*)(p.ws + WS_CAT); float* LSE = (float*)(p.ws + WS_LSE);
    asm volatile("" : "+v"(lane));
    const int r32 = lane & 31, h = lane >> 5;
    const int t = id & 31, rest = id >> 5, hd = rest % 12, chunk = rest / 12;
    int seq_base, S, cs;
    if (chunk < 16) { seq_base = (chunk >> 2) * PSEQ; S = PSEQ; cs = (chunk & 3) * 1024; }
    else { const int c2 = chunk - 16; seq_base = MP + (c2 >> 1) * SSEQ; S = SSEQ; cs = (c2 & 1) * 1024; }
    const int dsh = 2 * (hd >> 2), dil = 1 << dsh, L = S >> dsh;
    const int r = t & (dil - 1), blk = t >> dsh;
    const int i0 = (cs >> dsh) + blk * 32;
    const float slope = exp2f(-8.0f * (float)(hd + 1) / 12.0f);
    const float c_s = 0.125f * LOG2E, c_b = slope * (float)dil * LOG2E;
    const bf16_t* base = PROJ + (size_t)(seq_base + r) * NIN + hd * 64;
    const size_t rstride = (size_t)dil * NIN;
    bf16x8 bq[4];
    { const bf16_t* qp = base + QOFF + (size_t)(i0 + r32) * rstride + 8 * h;
#pragma unroll
      for (int s = 0; s < 4; ++s) bq[s] = *(const bf16x8*)(qp + 16 * s); }
    f32x16 sc[5];
#pragma unroll
    for (int kb = 0; kb < 5; ++kb) {
        int ki = i0 - 64 + kb * 32 + r32; ki = ki < 0 ? 0 : (ki > L - 1 ? L - 1 : ki);
        const bf16_t* kp = base + KOFF + (size_t)ki * rstride + 8 * h;
        bf16x8 ak[4];
#pragma unroll
        for (int s = 0; s < 4; ++s) ak[s] = *(const bf16x8*)(kp + 16 * s);
        f32x16 a;
#pragma unroll
        for (int i = 0; i < 16; ++i) a[i] = 0.f;
#pragma unroll
        for (int s = 0; s < 4; ++s) a = MFMA32(ak[s], bq[s], a);
        sc[kb] = a;
    }
    float mx = -1e30f;
    const float qoff = (float)(64 + r32 - 4 * h);
    const float lo = fmaxf(-64.0f, -(float)(i0 + r32)), hi = fminf(64.0f, (float)(L - 1 - i0 - r32));
#pragma unroll
    for (int kb = 0; kb < 5; ++kb)
#pragma unroll
        for (int i = 0; i < 16; ++i) { const float rel = (float)(kb * 32 + (i & 3) + 8 * (i >> 2)) - qoff;
            const bool valid = (rel >= lo) && (rel <= hi);
            float tv = sc[kb][i] * c_s - c_b * __builtin_fabsf(rel); tv = valid ? tv : -1e30f; sc[kb][i] = tv; mx = fmaxf(mx, tv); }
    mx = fmaxf(mx, __shfl_xor(mx, 32));
    float sum = 0.f;
#pragma unroll
    for (int kb = 0; kb < 5; ++kb)
#pragma unroll
        for (int i = 0; i < 16; ++i) { const float e = __builtin_amdgcn_exp2f(sc[kb][i] - mx); sum += e; sc[kb][i] = e; }
    sum += __shfl_xor(sum, 32);
    bf16x8 pb[5][2];
#pragma unroll
    for (int kb = 0; kb < 5; ++kb)
#pragma unroll
        for (int s = 0; s < 2; ++s) { u32x4 w; w.x = pk2(sc[kb][8 * s], sc[kb][8 * s + 1]); w.y = pk2(sc[kb][8 * s + 2], sc[kb][8 * s + 3]);
            w.z = pk2(sc[kb][8 * s + 4], sc[kb][8 * s + 5]); w.w = pk2(sc[kb][8 * s + 6], sc[kb][8 * s + 7]); pb[kb][s] = __builtin_bit_cast(bf16x8, w); }
    f32x16 o[2];
#pragma unroll
    for (int db = 0; db < 2; ++db)
#pragma unroll
        for (int i = 0; i < 16; ++i) o[db][i] = 0.f;
    const int i16 = lane & 15, tq = i16 >> 2, tp = i16 & 3, blk16 = (lane >> 4) & 1;
    const LAS unsigned char* trb = vbuf + (4 * h + tq) * V_SP + blk16 * 32 + 8 * tp;
#pragma unroll
    for (int kb = 0; kb < 5; ++kb) {
        bf16x8 vr[4];
#pragma unroll
        for (int i = 0; i < 4; ++i) { const int c = lane + 64 * i, row = c >> 3, c16 = c & 7; int ki = i0 - 64 + kb * 32 + row; ki = ki < 0 ? 0 : (ki > L - 1 ? L - 1 : ki);
            vr[i] = *(const bf16x8*)(base + VOFF + (size_t)ki * rstride + 8 * c16); }
        LDS_WAIT();
#pragma unroll
        for (int i = 0; i < 4; ++i) { const int c = lane + 64 * i, row = c >> 3, c16 = c & 7; *(LAS bf16x8*)(vbuf + row * V_SP + 16 * c16) = vr[i]; }
        LDS_WAIT();
#pragma unroll
        for (int s = 0; s < 2; ++s)
#pragma unroll
            for (int db = 0; db < 2; ++db) {
                const s16x4 lo = vtr(trb + (16 * s) * V_SP + 64 * db), hi = vtr(trb + (16 * s + 8) * V_SP + 64 * db);
                const bf16x8 va = __builtin_shufflevector(lo, hi, 0, 1, 2, 3, 4, 5, 6, 7);
                o[db] = MFMA32(va, pb[kb][s], o[db]);
            }
    }
    const float inv = __builtin_amdgcn_rcpf(sum);
    const int rowq = seq_base + (i0 + r32) * dil + r;
    bf16_t* op = CAT + (size_t)rowq * D + hd * 64 + 4 * h;
#pragma unroll
    for (int db = 0; db < 2; ++db)
#pragma unroll
        for (int g4 = 0; g4 < 4; ++g4) { u32x2 w; w.x = pk2(o[db][4 * g4] * inv, o[db][4 * g4 + 1] * inv); w.y = pk2(o[db][4 * g4 + 2] * inv, o[db][4 * g4 + 3] * inv);
            *(u32x2*)(op + 32 * db + 8 * g4) = w; }
    if (h == 0) LSE[(size_t)rowq * 12 + hd] = (mx + __log2f(sum)) * LN2;
}
__device__ __forceinline__ void phase3(const Params& p, LAS unsigned char* lds, int wave, int lane) {
    const int G = gridDim.x;
#ifndef NO_GMLP
    for (int n = blockIdx.x; n < M / 128; n += G) gmlp_item(p, n, lds, wave, lane);
#endif
    __syncthreads();
    LAS unsigned char* vbuf = lds + wave * V_BUF;
    constexpr int NTILES = (M / 32) * 12;
#ifndef NO_ATTN
    for (int g8 = blockIdx.x; g8 < NTILES / 8; g8 += G) attn_tile(p, g8 * 8 + wave, vbuf, lane);
#endif
}

__device__ __forceinline__ void phase4(const Params& p, int wave, int lane) {
    bf16_t* CAT = (bf16_t*)(p.ws + WS_CAT); const float* LSE = (const float*)(p.ws + WS_LSE);
    const int gw = blockIdx.x * 8 + wave, NGW = gridDim.x * 8;
    for (int m = gw; m < M; m += NGW) {
        const float* l = LSE + (size_t)m * 12;
        for (int c = lane; c < 96; c += 64) { const int hd = c >> 3, g = hd >> 2, j = hd & 3;
            const float l0 = l[j], l1 = l[4 + j], l2 = l[8 + j]; const float mxl = fmaxf(l0, fmaxf(l1, l2));
            const float e0 = __expf(l0 - mxl), e1 = __expf(l1 - mxl), e2 = __expf(l2 - mxl);
            const float w = (g == 0 ? e0 : (g == 1 ? e1 : e2)) / (e0 + e1 + e2);
            u32x4* q = (u32x4*)(CAT + (size_t)m * D) + c; u32x4 v = *q;
            v.x = pk2(bflo(v.x) * w, bfhi(v.x) * w); v.y = pk2(bflo(v.y) * w, bfhi(v.y) * w); v.z = pk2(bflo(v.z) * w, bfhi(v.z) * w); v.w = pk2(bflo(v.w) * w, bfhi(v.w) * w);
            *q = v; }
    }
}

__device__ __forceinline__ void phase6(const Params& p, int wave, int lane) {
    const float* mod = (const float*)(p.ws + WS_MOD); bf16_t* XN = (bf16_t*)(p.ws + WS_XN); const bf16_t* MIX = (const bf16_t*)(p.ws + WS_PROJ);
    const int gw = blockIdx.x * 8 + wave, NGW = gridDim.x * 8;
    for (int item = gw; item < M / 8; item += NGW) {
        const int m0 = item * 8; const float* mb = mod + batch_of(m0) * NMOD;
        f32x4 a1[4], gs[4], sh[4];
#pragma unroll
        for (int j = 0; j < 4; ++j) { const int o = lane + 64 * j;
            a1[j] = ((const f32x4*)(mb + 2 * D))[o] * ((const f32x4*)p.g_post_mix)[o];
            gs[j] = ((const f32x4*)p.g_pre_ffn)[o] * (1.0f + ((const f32x4*)(mb + 4 * D))[o]); sh[j] = ((const f32x4*)(mb + 3 * D))[o]; }
        for (int r = 0; r < 8; ++r) { const int m = m0 + r; const f32x4* xr = (const f32x4*)xrow_ptr(p, m) + lane; const u32x2* mr = (const u32x2*)(MIX + (size_t)m * D) + lane;
            f32x4 v[4], y[4]; float ss = 0.f;
#pragma unroll
            for (int j = 0; j < 4; ++j) { v[j] = xr[64 * j]; const u32x2 w = mr[64 * j]; y[j] = (f32x4){bflo(w.x), bfhi(w.x), bflo(w.y), bfhi(w.y)};
                ss += (y[j][0] * y[j][0] + y[j][1] * y[j][1]) + (y[j][2] * y[j][2] + y[j][3] * y[j][3]); }
            const float rstd = rsqrtf(wave_sum(ss) * (1.0f / D) + RMS_EPS);
            f32x4* orow = (f32x4*)(p.out + (size_t)m * D) + lane; float s2 = 0.f;
#pragma unroll
            for (int j = 0; j < 4; ++j) { v[j] = v[j] + a1[j] * (y[j] * rstd); orow[64 * j] = v[j]; s2 += (v[j][0] * v[j][0] + v[j][1] * v[j][1]) + (v[j][2] * v[j][2] + v[j][3] * v[j][3]); }
            const float rstd2 = rsqrtf(wave_sum(s2) * (1.0f / D) + RMS_EPS);
            u32x2* o8 = (u32x2*)(XN + (size_t)m * D) + lane;
#pragma unroll
            for (int j = 0; j < 4; ++j) { const f32x4 hh = v[j] * rstd2 * gs[j] + sh[j]; u32x2 w; w.x = pk2(hh[0], hh[1]); w.y = pk2(hh[2], hh[3]); o8[64 * j] = w; }
        }
    }
}
__device__ __forceinline__ void phase9(const Params& p, int wave, int lane) {
    const float* mod = (const float*)(p.ws + WS_MOD); const bf16_t* FB = (const bf16_t*)(p.ws + WS_CAT);
    const int gw = blockIdx.x * 8 + wave, NGW = gridDim.x * 8;
    for (int item = gw; item < M / 8; item += NGW) {
        const int m0 = item * 8; const float* mb = mod + batch_of(m0) * NMOD;
        f32x4 a2[4];
#pragma unroll
        for (int j = 0; j < 4; ++j) { const int o = lane + 64 * j; a2[j] = ((const f32x4*)(mb + 5 * D))[o] * ((const f32x4*)p.g_post_ffn)[o]; }
        for (int r = 0; r < 8; ++r) { const int m = m0 + r; f32x4* orow = (f32x4*)(p.out + (size_t)m * D) + lane; const u32x2* fr = (const u32x2*)(FB + (size_t)m * D) + lane;
            f32x4 v[4], y[4]; float ss = 0.f;
#pragma unroll
            for (int j = 0; j < 4; ++j) { v[j] = orow[64 * j]; const u32x2 w = fr[64 * j]; y[j] = (f32x4){bflo(w.x), bfhi(w.x), bflo(w.y), bfhi(w.y)};
                ss += (y[j][0] * y[j][0] + y[j][1] * y[j][1]) + (y[j][2] * y[j][2] + y[j][3] * y[j][3]); }
            const float rstd = rsqrtf(wave_sum(ss) * (1.0f / D) + RMS_EPS);
#pragma unroll
            for (int j = 0; j < 4; ++j) orow[64 * j] = v[j] + a2[j] * (y[j] * rstd);
        }
    }
}

__global__ void __launch_bounds__(512, 2) fwd_megakernel(Params p) {
    extern __shared__ __attribute__((aligned(16))) unsigned char lds_raw[];
    LAS unsigned char* lds = (LAS unsigned char*)lds_raw;
    cg::grid_group grid = cg::this_grid();
    const int tid = threadIdx.x, lane = tid & 63, wave = __builtin_amdgcn_readfirstlane(tid >> 6);
    const int G = gridDim.x;
    unsigned char* ws = p.ws;
#define IN(k) (p.ph_lo <= (k) && (k) < p.ph_hi)
#define SEAM(k) do { if (IN(k) && IN((k) + 1)) grid.sync(); } while (0)
#ifndef NO_P0
    if (IN(0)) phase0(p, lds, tid, wave, lane);
#endif
    SEAM(0);
#ifndef NO_P1
    if (IN(1)) phase1(p, wave, lane);
#endif
    SEAM(1);
#ifndef NO_GEMM
    if (IN(2)) {
        pg8::Gemm g{(const bf16_t*)(ws + WS_XN), (const bf16_t*)(ws + WS_WIN), M, NIN, D}; pg8::StaticOrder S; S.init(M, NIN, G, (int)blockIdx.x);
        pg8::EpiStore E{(bf16_t*)(ws + WS_PROJ), NIN};
        pg8::gemm_phase<pg8::EpiStore, pg8::StaticOrder, true, true>(lds, g, S, E);
    }
#endif
    SEAM(2);
#ifndef NO_P3
    if (IN(3)) phase3(p, lds, wave, lane);
#endif
    SEAM(3);
#ifndef NO_P4
    if (IN(4)) phase4(p, wave, lane);
#endif
    SEAM(4);
    if (IN(5)) {
        pg8::Gemm g{(const bf16_t*)(ws + WS_CAT), (const bf16_t*)(ws + WS_WOUT), M, D, D}; pg8::StaticOrder S; S.init(M, D, G, (int)blockIdx.x);
        pg8::EpiStore E{(bf16_t*)(ws + WS_PROJ), D};
        pg8::gemm_phase<pg8::EpiStore, pg8::StaticOrder, true, true>(lds, g, S, E);
    }
    SEAM(5);
#ifndef NO_P6
    if (IN(6)) phase6(p, wave, lane);
#endif
    SEAM(6);
    if (IN(7)) {
        pg8::Gemm g{(const bf16_t*)(ws + WS_XN), (const bf16_t*)(ws + WS_WGU), M, 2 * NFF, D}; pg8::StaticOrder S; S.init(M, 2 * NFF, G, (int)blockIdx.x);
        pg8::EpiSwiGLU E{(bf16_t*)(ws + WS_PROJ), NFF};
        pg8::gemm_phase<pg8::EpiSwiGLU, pg8::StaticOrder, true, true>(lds, g, S, E);
    }
    SEAM(7);
    if (IN(8)) {
        pg8::Gemm g{(const bf16_t*)(ws + WS_PROJ), (const bf16_t*)(ws + WS_WDN), M, D, NFF}; pg8::StaticOrder S; S.init(M, D, G, (int)blockIdx.x);
        pg8::EpiStore E{(bf16_t*)(ws + WS_CAT), D};
        pg8::gemm_phase<pg8::EpiStore, pg8::StaticOrder, true, true>(lds, g, S, E);
    }
    SEAM(8);
#ifndef NO_P9
    if (IN(9)) phase9(p, wave, lane);
#endif
#undef IN
#undef SEAM
}

#ifndef MK_N_LAUNCHES
#define MK_N_LAUNCHES 1
#endif
extern "C" void kernel_launch(void* const* d_in, const int* in_sizes, int n_in, void* d_out, int out_size, void* d_ws, size_t ws_size, hipStream_t stream) {
    static int grid = 0;
    if (grid == 0) {
        if (n_in != 17 || out_size != M * D || ws_size < WS_END) { fprintf(stderr, "kernel_launch: unexpected sizes (n_in %d, out %d, ws %zu)\n", n_in, out_size, ws_size); grid = -1; return; }
        int dev = 0, cus = 0, per_cu = 0;
        if (hipGetDevice(&dev) != hipSuccess || hipDeviceGetAttribute(&cus, hipDeviceAttributeMultiprocessorCount, dev) != hipSuccess) { grid = -1; return; }
        if (hipFuncSetAttribute((const void*)fwd_megakernel, hipFuncAttributeMaxDynamicSharedMemorySize, LDS_BYTES) != hipSuccess) { fprintf(stderr, "kernel_launch: hipFuncSetAttribute failed\n"); grid = -1; return; }
        if (hipOccupancyMaxActiveBlocksPerMultiprocessor(&per_cu, (const void*)fwd_megakernel, 512, LDS_BYTES) != hipSuccess || per_cu < 1) { fprintf(stderr, "kernel_launch: occupancy query reports %d\n", per_cu); grid = -1; return; }
        grid = cus;
    }
    if (grid < 0) return;
    Params p{};
    p.x_prompt = (const float*)d_in[0]; p.x_sample = (const float*)d_in[1]; p.c_prompt = (const float*)d_in[2]; p.c_sample = (const float*)d_in[3];
    p.w_ada = (const float*)d_in[4]; p.b_ada = (const float*)d_in[5]; p.g_pre_mix = (const float*)d_in[6]; p.w_in = (const float*)d_in[7];
    p.w_s = (const float*)d_in[8]; p.b_s = (const float*)d_in[9]; p.g_gmlp = (const float*)d_in[10]; p.w_out = (const float*)d_in[11];
    p.g_post_mix = (const float*)d_in[12]; p.g_pre_ffn = (const float*)d_in[13]; p.w_gu = (const float*)d_in[14]; p.w_down = (const float*)d_in[15]; p.g_post_ffn = (const float*)d_in[16];
    p.out = (float*)d_out; p.ws = (unsigned char*)d_ws;
#if MK_N_LAUNCHES == 1
    p.ph_lo = 0; p.ph_hi = 10;
    void* args[] = {&p};
    const hipError_t e = hipLaunchCooperativeKernel((const void*)fwd_megakernel, dim3(grid), dim3(512), args, LDS_BYTES, stream);
    if (e != hipSuccess) fprintf(stderr, "kernel_launch: cooperative launch failed: %s (grid %d)\n", hipGetErrorString(e), grid);
#else
    for (int k = 0; k < 10; ++k) { p.ph_lo = k; p.ph_hi = k + 1; hipLaunchKernelGGL(fwd_megakernel, dim3(grid), dim3(512), LDS_BYTES, stream, p); }
#endif
}
```

```cpp
#include <hip/hip_runtime.h>
#include <hip/hip_cooperative_groups.h>
#include <cstdio>
#include <cstdint>
namespace cg = cooperative_groups;
namespace pg8 {
#define PG8_LAS __attribute__((address_space(3)))
typedef unsigned short bf16_t;
typedef short bf16x8 __attribute__((ext_vector_type(8)));
typedef float f32x4 __attribute__((ext_vector_type(4)));
typedef unsigned u32x4 __attribute__((ext_vector_type(4)));
constexpr int BM = 256, BK = 64, HALF = 128, HTB = HALF * BK * 2  , STAGE_BYTES = 8 * HTB, NXCD = 8, WGM = 8;

__host__ __device__ __forceinline__ int lds_byte(int r, int c) { const int st = (r >> 4) * 2 + (c >> 5), rr = r & 15, cc = c & 31, ob = rr * 64 + cc * 2; return st * 1024 + (ob ^ (((ob >> 9) & 1) << 5)); }
__host__ __device__ __forceinline__ void stage_rc(int b, int& R, int& C) { const int st = b / 1024, sb = b % 1024, swz = sb ^ (((sb >> 9) & 1) << 5); R = (st >> 1) * 16 + swz / 64; C = (st & 1) * 32 + (swz % 64) / 2; }
__host__ __device__ __forceinline__ int perm32(int rho) { const int n = rho >> 4, i = rho & 15; return 8 * (i >> 2) + 4 * n + (i & 3); }

struct Unit { int pm, pn; };
struct Gemm { const bf16_t* A; const bf16_t* Bt; int M, N, K; };

struct StaticOrder {
    int nM, nN, nwg, G, c;
    __host__ __device__ void init(int M, int N, int G_, int c_) { nM = M / BM; nN = N / BM; nwg = nM * nN; G = G_; c = c_; }
    __host__ __device__ bool next(int i, Unit& u) const {
        const long L = (long)i * G + c; if (L >= nwg) return false;
        int wgid = (int)L; { const int q = nwg / NXCD, r = nwg % NXCD, xcd = wgid % NXCD, off = wgid / NXCD; wgid = (xcd < r ? xcd * (q + 1) : r * (q + 1) + (xcd - r) * q) + off; }
        const int nig = WGM * nN, gid = wgid / nig, fm = gid * WGM, gsz = (nM - fm) < WGM ? (nM - fm) : WGM;
        u.pm = fm + ((wgid % nig) % gsz); u.pn = (wgid % nig) / gsz; return true;
    }
    __device__ __forceinline__ void a_ready(const Unit&) const {}
    __device__ __forceinline__ void done(const Unit&) const {}
};

__device__ __forceinline__ unsigned cvt_pk_bf16(float lo, float hi) { unsigned r; asm volatile("v_cvt_pk_bf16_f32 %0, %1, %2" : "=v"(r) : "v"(lo), "v"(hi)); return r; }
typedef float f32x2 __attribute__((ext_vector_type(2)));
struct EpiStore {
    static constexpr bool PERM = true, AFTER_DRAIN = false;
    bf16_t* O; int ldc;
    __device__ __forceinline__ void operator()(const f32x4 (&acc)[2][2][4][2], const Unit& u, int wr, int wc, int fr, int fq) const {
        const int row0 = u.pm * BM + wr * 64 + fr; const int col0 = u.pn * BM + wc * 32 + 8 * fq;
#pragma unroll
        for (int ai = 0; ai < 2; ++ai)
#pragma unroll
            for (int m = 0; m < 4; ++m) { bf16_t* rowp = O + (size_t)(row0 + ai * HALF + m * 16) * ldc + col0;
#pragma unroll
                for (int bj = 0; bj < 2; ++bj) { const f32x4 v0 = acc[ai][bj][m][0], v1 = acc[ai][bj][m][1];
                    u32x4 w; w.x = cvt_pk_bf16(v0[0], v0[1]); w.y = cvt_pk_bf16(v0[2], v0[3]); w.z = cvt_pk_bf16(v1[0], v1[1]); w.w = cvt_pk_bf16(v1[2], v1[3]);
                    *(u32x4*)(rowp + bj * HALF) = w; } }
    }
};
__device__ __forceinline__ float silu_f(float g) { return g * __builtin_amdgcn_rcpf(1.0f + __builtin_amdgcn_exp2f(-1.44269504089f * g)); }
struct EpiSwiGLU {
    static constexpr bool PERM = true, AFTER_DRAIN = false;
    bf16_t* O; int ldc;
    __device__ __forceinline__ void operator()(const f32x4 (&acc)[2][2][4][2], const Unit& u, int wr, int wc, int fr, int fq) const {
        const int row0 = u.pm * BM + wr * 64 + fr; const int col0 = u.pn * HALF + wc * 32 + 8 * fq;
#pragma unroll
        for (int ai = 0; ai < 2; ++ai)
#pragma unroll
            for (int m = 0; m < 4; ++m) { bf16_t* rowp = O + (size_t)(row0 + ai * HALF + m * 16) * ldc + col0;
                const f32x4 g0 = acc[ai][0][m][0], g1 = acc[ai][0][m][1], u0 = acc[ai][1][m][0], u1 = acc[ai][1][m][1];
                u32x4 w;
                w.x = cvt_pk_bf16(silu_f(g0[0]) * u0[0], silu_f(g0[1]) * u0[1]); w.y = cvt_pk_bf16(silu_f(g0[2]) * u0[2], silu_f(g0[3]) * u0[3]);
                w.z = cvt_pk_bf16(silu_f(g1[0]) * u1[0], silu_f(g1[1]) * u1[1]); w.w = cvt_pk_bf16(silu_f(g1[2]) * u1[2], silu_f(g1[3]) * u1[3]);
                *(u32x4*)rowp = w; }
    }
};
template <class Epi, class Sched, bool ALIGN_EPI = false, bool SP2 = false>
__device__ __forceinline__ void gemm_phase(PG8_LAS unsigned char* lds, const Gemm g, const Sched& S, const Epi& E) {
    int tid_o = threadIdx.x; asm volatile("" : "+v"(tid_o));
    const int tid = tid_o, wid = __builtin_amdgcn_readfirstlane(tid >> 6), lane = tid & 63, wr = wid >> 2, wc = wid & 3, fr = lane & 15, fq = lane >> 4;
    const int K = g.K, nt = K / BK;
    unsigned voffA[2], voffB[2];
#pragma unroll
    for (int i = 0; i < 2; ++i) { int R, C; stage_rc(tid * 16 + i * 8192, R, C); const int Rb = Epi::PERM ? ((R & ~31) + perm32(R & 31)) : R;
        voffA[i] = (unsigned)(R * K + C) * 2u; voffB[i] = (unsigned)(Rb * K + C) * 2u; }
    const size_t kstep = (size_t)(BK * 2);
    const size_t hstep = (size_t)HALF * K * 2;
    const size_t tstep = 2 * hstep;
    const unsigned ldsw = (unsigned)wid * 1024u;
    const int aoff = lds_byte(wr * 64 + fr, fq * 8), boff = lds_byte(wc * 32 + fr, fq * 8);
#define PG8_SA(b, h) (((b) * 2 + (h)) * HTB)
#define PG8_SB(b, h) ((4 + (b) * 2 + (h)) * HTB)
#define PG8_STAGE(bufoff, gbase, voff) do { _Pragma("unroll") for (int _i = 0; _i < 2; ++_i) \
        __builtin_amdgcn_global_load_lds((const unsigned*)((const char*)(gbase) + (voff)[_i]), (PG8_LAS unsigned*)(lds + (bufoff) + ldsw + _i * 8192), 16, 0, 0); } while (0)
#define PG8_LDA(dst, b, h) do { _Pragma("unroll") for (int m = 0; m < 4; ++m) _Pragma("unroll") for (int k = 0; k < 2; ++k) dst[m][k] = *(const PG8_LAS bf16x8*)(lds + PG8_SA(b, h) + aoff + m * 2048 + k * 1024); } while (0)
#define PG8_LDB(dst, b, h) do { _Pragma("unroll") for (int n = 0; n < 2; ++n) _Pragma("unroll") for (int k = 0; k < 2; ++k) dst[n][k] = *(const PG8_LAS bf16x8*)(lds + PG8_SB(b, h) + boff + n * 2048 + k * 1024); } while (0)
#define PG8_MMA(ai, bj, At, Bt) do { __builtin_amdgcn_s_setprio(1); _Pragma("unroll") for (int m = 0; m < 4; ++m) _Pragma("unroll") for (int n = 0; n < 2; ++n) _Pragma("unroll") for (int k = 0; k < 2; ++k) \
        acc[ai][bj][m][n] = __builtin_amdgcn_mfma_f32_16x16x32_bf16(Bt[n][k], At[m][k], acc[ai][bj][m][n], 0, 0, 0); __builtin_amdgcn_s_setprio(0); } while (0)
#define PG8_WAIT_V(n) asm volatile("s_waitcnt vmcnt(" #n ")" ::: "memory")
#define PG8_WAIT_L(n) asm volatile("s_waitcnt lgkmcnt(" #n ")" ::: "memory")
#define PG8_BAR __builtin_amdgcn_s_barrier()
#define PG8_SCHED __builtin_amdgcn_sched_barrier(0)
    Unit cur, nxt; int ui = 0;
    if (!S.next(0, cur)) return;
    f32x4 acc[2][2][4][2];
#pragma unroll
    for (int a = 0; a < 2; ++a)
#pragma unroll
        for (int b = 0; b < 2; ++b)
#pragma unroll
            for (int m = 0; m < 4; ++m)
#pragma unroll
                for (int n = 0; n < 2; ++n) acc[a][b][m][n] = (f32x4){0.f, 0.f, 0.f, 0.f};
    bf16x8 At[4][2], B0[2][2], B1[2][2];
    const char* cA = (const char*)g.A + (size_t)cur.pm * tstep; const char* cB = (const char*)g.Bt + (size_t)cur.pn * tstep;
    S.a_ready(cur);
    if constexpr (SP2) {
        PG8_STAGE(PG8_SB(0, 0), cB, voffB); PG8_STAGE(PG8_SB(0, 1), cB + hstep, voffB); PG8_STAGE(PG8_SA(0, 0), cA, voffA); PG8_STAGE(PG8_SA(0, 1), cA + hstep, voffA);
        if (wr == 1) PG8_BAR;
        PG8_WAIT_V(2); PG8_BAR;
        PG8_STAGE(PG8_SB(1, 0), cB + kstep, voffB); PG8_STAGE(PG8_SA(1, 0), cA + kstep, voffA); PG8_STAGE(PG8_SB(1, 1), cB + hstep + kstep, voffB);
        PG8_WAIT_V(6); PG8_BAR;
    } else {
        PG8_STAGE(PG8_SB(0, 0), cB, voffB); PG8_STAGE(PG8_SA(0, 0), cA, voffA); PG8_STAGE(PG8_SB(0, 1), cB + hstep, voffB); PG8_STAGE(PG8_SA(0, 1), cA + hstep, voffA);
        if (wr == 1) PG8_BAR;
        PG8_WAIT_V(4); PG8_BAR;
        PG8_STAGE(PG8_SB(1, 0), cB + kstep, voffB); PG8_STAGE(PG8_SA(1, 0), cA + kstep, voffA); PG8_STAGE(PG8_SB(1, 1), cB + hstep + kstep, voffB);
        PG8_WAIT_V(6); PG8_BAR;
    }
    for (;;) {
        const bool has_next = S.next(ui + 1, nxt);
        const char* nA = has_next ? (const char*)g.A + (size_t)nxt.pm * tstep : cA; const char* nB = has_next ? (const char*)g.Bt + (size_t)nxt.pn * tstep : cB;
        for (int t = 0; t < nt; t += 2) {
            const bool last = (t == nt - 2);
            const char* a1 = cA + (size_t)(t + 1) * kstep;
            const char* a2 = last ? nA : cA + (size_t)(t + 2) * kstep; const char* b2 = last ? nB : cB + (size_t)(t + 2) * kstep;
            const char* a3 = a2 + kstep; const char* b3 = b2 + kstep;
            if (last && has_next) S.a_ready(nxt);
            if constexpr (SP2) {
            PG8_LDB(B0, 0, 0); PG8_LDB(B1, 0, 1); PG8_SCHED; PG8_LDA(At, 0, 0); PG8_STAGE(PG8_SA(1, 1), a1 + hstep, voffA);
            PG8_WAIT_V(8); PG8_WAIT_L(0); PG8_BAR; PG8_MMA(0, 0, At, B0); PG8_MMA(0, 1, At, B1); PG8_BAR; PG8_SCHED;
            PG8_LDA(At, 0, 1); PG8_STAGE(PG8_SB(0, 0), b2, voffB); PG8_STAGE(PG8_SB(0, 1), b2 + hstep, voffB); PG8_STAGE(PG8_SA(0, 0), a2, voffA);
            PG8_WAIT_V(8); PG8_WAIT_L(0); PG8_BAR; PG8_MMA(1, 0, At, B0); PG8_MMA(1, 1, At, B1); PG8_BAR; PG8_SCHED;
            PG8_LDB(B0, 1, 0); PG8_LDB(B1, 1, 1); PG8_SCHED; PG8_LDA(At, 1, 0); PG8_STAGE(PG8_SA(0, 1), a2 + hstep, voffA);
            PG8_WAIT_V(8); PG8_WAIT_L(0); PG8_BAR; PG8_MMA(0, 0, At, B0); PG8_MMA(0, 1, At, B1); PG8_BAR; PG8_SCHED;
            PG8_LDA(At, 1, 1); PG8_STAGE(PG8_SB(1, 0), b3, voffB); PG8_STAGE(PG8_SB(1, 1), b3 + hstep, voffB); PG8_STAGE(PG8_SA(1, 0), a3, voffA);
            PG8_WAIT_V(8); PG8_WAIT_L(0); PG8_BAR; PG8_MMA(1, 0, At, B0); PG8_MMA(1, 1, At, B1); PG8_BAR; PG8_SCHED;
            } else {
            PG8_LDB(B0, 0, 0); PG8_SCHED; PG8_LDA(At, 0, 0); PG8_STAGE(PG8_SA(1, 1), a1 + hstep, voffA);
            PG8_WAIT_L(8); PG8_BAR; PG8_WAIT_L(0); PG8_MMA(0, 0, At, B0); PG8_BAR; PG8_SCHED;
            PG8_LDB(B1, 0, 1); PG8_STAGE(PG8_SB(0, 0), b2, voffB);
            PG8_BAR; PG8_WAIT_L(0); PG8_MMA(0, 1, At, B1); PG8_BAR;
            PG8_LDA(At, 0, 1); PG8_STAGE(PG8_SA(0, 0), a2, voffA);
            PG8_BAR; PG8_WAIT_L(0); PG8_MMA(1, 0, At, B0); PG8_BAR; PG8_SCHED;
            PG8_STAGE(PG8_SB(0, 1), b2 + hstep, voffB);
            PG8_WAIT_V(6); PG8_BAR; PG8_MMA(1, 1, At, B1); PG8_BAR;
            PG8_LDB(B0, 1, 0); PG8_SCHED; PG8_LDA(At, 1, 0); PG8_STAGE(PG8_SA(0, 1), a2 + hstep, voffA);
            PG8_WAIT_L(8); PG8_BAR; PG8_WAIT_L(0); PG8_MMA(0, 0, At, B0); PG8_BAR; PG8_SCHED;
            PG8_LDB(B1, 1, 1); PG8_STAGE(PG8_SB(1, 0), b3, voffB);
            PG8_BAR; PG8_WAIT_L(0); PG8_MMA(0, 1, At, B1); PG8_BAR;
            PG8_LDA(At, 1, 1); PG8_STAGE(PG8_SA(1, 0), a3, voffA);
            PG8_BAR; PG8_WAIT_L(0); PG8_MMA(1, 0, At, B0); PG8_BAR; PG8_SCHED;
            PG8_STAGE(PG8_SB(1, 1), b3 + hstep, voffB);
            PG8_WAIT_V(6); PG8_BAR; PG8_MMA(1, 1, At, B1); PG8_BAR;
            }
        }
        if constexpr (ALIGN_EPI) { if (wr == 0) PG8_BAR; }
        if constexpr (!Epi::AFTER_DRAIN) { E(acc, cur, wr, wc, fr, fq); S.done(cur); }
        if (!has_next) break;
#pragma unroll
        for (int a = 0; a < 2; ++a)
#pragma unroll
            for (int b = 0; b < 2; ++b)
#pragma unroll
                for (int m = 0; m < 4; ++m)
#pragma unroll
                    for (int n = 0; n < 2; ++n) acc[a][b][m][n] = (f32x4){0.f, 0.f, 0.f, 0.f};
        cur = nxt; cA = nA; cB = nB; ++ui;
        if constexpr (ALIGN_EPI) { if (wr == 1) PG8_BAR; }
    }
    PG8_WAIT_V(0);
    if constexpr (!ALIGN_EPI) { if (wr == 0) PG8_BAR; }
    PG8_BAR;
    if constexpr (Epi::AFTER_DRAIN) { E.fused(acc, cur, wr, wc, fr, fq, lds, wid, lane); S.done(cur); }
#undef PG8_SA
#undef PG8_SB
#undef PG8_STAGE
#undef PG8_LDA
#undef PG8_LDB
#undef PG8_MMA
#undef PG8_WAIT_V
#undef PG8_WAIT_L
#undef PG8_BAR
#undef PG8_SCHED
}
}

constexpr int D = 1024, NPB = 4, PSEQ = 4096, NSB = 16, SSEQ = 2048, NB = NPB + NSB;
constexpr int MP = NPB * PSEQ;
constexpr int M = MP + NSB * SSEQ;
constexpr int NIN = 2816, NFF = 2816, NMOD = 6 * D;
constexpr int QOFF = 0, KOFF = 768, VOFF = 1536, GUOFF = 2304, GVOFF = 2560;
constexpr float RMS_EPS = 1e-6f, LN_EPS = 1e-5f, LOG2E = 1.44269504089f, LN2 = 0.69314718056f;
constexpr size_t MiB = 1u << 20;
constexpr size_t WS_MOD = 0;
constexpr size_t WS_BAR = 512 * 1024;
constexpr size_t WS_WIN = 1 * MiB, WS_WOUT = 7 * MiB, WS_WGU = 9 * MiB, WS_WDN = 20 * MiB, WS_WSB = 26 * MiB;
constexpr size_t WS_LSE = 27 * MiB;
constexpr size_t WS_XN = 30 * MiB;
constexpr size_t WS_CAT = 126 * MiB;
constexpr size_t WS_PROJ = 222 * MiB;
constexpr size_t WS_END = 486 * MiB;
constexpr int LDS_BYTES = 147456;

#define LAS __attribute__((address_space(3)))
typedef unsigned short bf16_t;
typedef short bf16x8 __attribute__((ext_vector_type(8)));
typedef short s16x4 __attribute__((ext_vector_type(4)));
typedef short v4i16_t __attribute__((ext_vector_type(4)));
typedef float f32x4 __attribute__((ext_vector_type(4)));
typedef float f32x16 __attribute__((ext_vector_type(16)));
typedef unsigned u32x4 __attribute__((ext_vector_type(4)));
typedef unsigned u32x2 __attribute__((ext_vector_type(2)));
#define LDS_WAIT() asm volatile("s_waitcnt lgkmcnt(0)" ::: "memory")
#define MFMA32(a, b, c) __builtin_amdgcn_mfma_f32_32x32x16_bf16((a), (b), (c), 0, 0, 0)

struct Params {
    const float *x_prompt, *x_sample, *c_prompt, *c_sample, *w_ada, *b_ada, *g_pre_mix, *w_in, *w_s, *b_s, *g_gmlp, *w_out, *g_post_mix, *g_pre_ffn, *w_gu, *w_down, *g_post_ffn;
    float* out; unsigned char* ws; int ph_lo, ph_hi, rep_phase, rep_count;
};

__device__ __forceinline__ unsigned pk2(float lo, float hi) { return pg8::cvt_pk_bf16(lo, hi); }
__device__ __forceinline__ float bf2f(short v) { return __uint_as_float(((unsigned)(unsigned short)v) << 16); }
__device__ __forceinline__ float bflo(unsigned w) { return __uint_as_float(w << 16); }
__device__ __forceinline__ float bfhi(unsigned w) { return __uint_as_float(w & 0xffff0000u); }
__device__ __forceinline__ float wave_sum(float v) {
#pragma unroll
    for (int o = 1; o < 64; o <<= 1) v += __shfl_xor(v, o);
    return v;
}
__device__ __forceinline__ float gelu_tanh(float x) {
    const float y = 0.7978845608f * (x + 0.044715f * x * x * x);
    return x * __builtin_amdgcn_rcpf(1.0f + __builtin_amdgcn_exp2f(-2.0f * LOG2E * y));
}
__device__ __forceinline__ int crow(int i, int h) { return (i & 3) + 8 * (i >> 2) + 4 * h; }
__device__ __forceinline__ const float* xrow_ptr(const Params& p, int m) { return m < MP ? p.x_prompt + (size_t)m * D : p.x_sample + (size_t)(m - MP) * D; }
__device__ __forceinline__ int batch_of(int m) { return m < MP ? (m >> 12) : NPB + ((m - MP) >> 11); }

__device__ __forceinline__ void transpose_item(const float* W, int K, int N, bf16_t* WT, int k0, int n0, int drow0, LAS float* scr, int lane) {
#pragma unroll 8
    for (int i = 0; i < 32; ++i) { const int kk = 2 * i + (lane >> 5); scr[kk * 33 + (lane & 31)] = W[(size_t)(k0 + kk) * N + n0 + (lane & 31)]; }
    LDS_WAIT();
    const int c = lane & 7;
#pragma unroll
    for (int j = 0; j < 4; ++j) { const int n = (lane >> 3) + 8 * j; const LAS float* s = scr + (8 * c) * 33 + n;
        u32x4 o; o.x = pk2(s[0 * 33], s[1 * 33]); o.y = pk2(s[2 * 33], s[3 * 33]); o.z = pk2(s[4 * 33], s[5 * 33]); o.w = pk2(s[6 * 33], s[7 * 33]);
        *(u32x4*)(WT + (size_t)(drow0 + n) * K + k0 + 8 * c) = o; }
    LDS_WAIT();
}
__device__ __forceinline__ void phase0(const Params& p, LAS unsigned char* lds, int tid, int wave, int lane) {
    unsigned char* ws = p.ws;
    const int G = gridDim.x;
    if (blockIdx.x < 192) {
        LAS float* sc = (LAS float*)lds;
        LAS float* red = (LAS float*)(lds + 81920);
        float* mod = (float*)(ws + WS_MOD);
        for (int idx = tid; idx < NB * D; idx += 512) { const int b = idx >> 10, k = idx & 1023;
            const float c = b < NPB ? p.c_prompt[b * D + k] : p.c_sample[(b - NPB) * D + k];
            sc[k * NB + b] = c / (1.0f + __expf(-c)); }
        __syncthreads();
        for (int item = blockIdx.x; item < 192; item += G) {
            const int col = 32 * item + (lane & 31);
            float acc[NB];
#pragma unroll
            for (int b = 0; b < NB; ++b) acc[b] = 0.f;
            const int k0 = wave * 128 + (lane >> 5);
#pragma unroll 8
            for (int it = 0; it < 64; ++it) { const int k = k0 + 2 * it; const float w = p.w_ada[(size_t)k * NMOD + col];
                const LAS f32x4* s4 = (const LAS f32x4*)(sc + k * NB);
#pragma unroll
                for (int q = 0; q < 5; ++q) { const f32x4 s = s4[q]; acc[4 * q] += w * s[0]; acc[4 * q + 1] += w * s[1]; acc[4 * q + 2] += w * s[2]; acc[4 * q + 3] += w * s[3]; } }
#pragma unroll
            for (int b = 0; b < NB; ++b) acc[b] += __shfl_xor(acc[b], 32);
            if (lane < 32) {
#pragma unroll
                for (int b = 0; b < NB; ++b) red[(wave * NB + b) * 32 + lane] = acc[b]; }
            __syncthreads();
            for (int idx = tid; idx < NB * 32; idx += 512) { const int b = idx >> 5, c = idx & 31; float s = 0.f;
#pragma unroll
                for (int w = 0; w < 8; ++w) s += red[(w * NB + b) * 32 + c];
                mod[b * NMOD + 32 * item + c] = s + p.b_ada[32 * item + c]; }
            __syncthreads();
        }
    }
    __syncthreads();
    const int gw = blockIdx.x * 8 + wave, NGW = G * 8;
    LAS float* scr = (LAS float*)(lds + wave * 16384);
    constexpr int I_IN = 16 * 88, I_OUT = 16 * 32, I_GU = 16 * 176, I_DN = 44 * 32, NITEMS = I_IN + I_OUT + I_GU + I_DN;
    for (int it = gw; it < NITEMS; it += NGW) {
        int r = it;
        if (r < I_IN) { const int kb = r / 88, nb = r % 88; transpose_item(p.w_in, D, NIN, (bf16_t*)(ws + WS_WIN), 64 * kb, 32 * nb, 32 * nb, scr, lane); continue; } r -= I_IN;
        if (r < I_OUT) { const int kb = r / 32, nb = r % 32; transpose_item(p.w_out, D, D, (bf16_t*)(ws + WS_WOUT), 64 * kb, 32 * nb, 32 * nb, scr, lane); continue; } r -= I_OUT;
        if (r < I_GU) { const int kb = r / 176, nb = r % 176; const int n0 = 32 * nb; const int up = n0 >= NFF ? 1 : 0; const int j0 = n0 - up * NFF;
            const int drow0 = (j0 >> 7) * 256 + up * 128 + (j0 & 127);
            transpose_item(p.w_gu, D, 2 * NFF, (bf16_t*)(ws + WS_WGU), 64 * kb, n0, drow0, scr, lane); continue; } r -= I_GU;
        { const int kb = r / 32, nb = r % 32; transpose_item(p.w_down, NFF, D, (bf16_t*)(ws + WS_WDN), 64 * kb, 32 * nb, 32 * nb, scr, lane); }
    }
    for (int i = blockIdx.x * 512 + tid; i < 4 * 128 * 128 / 8; i += G * 512) {
        const f32x4 a = ((const f32x4*)p.w_s)[2 * i], b = ((const f32x4*)p.w_s)[2 * i + 1];
        u32x4 o; o.x = pk2(a[0], a[1]); o.y = pk2(a[2], a[3]); o.z = pk2(b[0], b[1]); o.w = pk2(b[2], b[3]);
        ((u32x4*)(ws + WS_WSB))[i] = o; }
}

__device__ __forceinline__ void phase1(const Params& p, int wave, int lane) {
    const float* mod = (const float*)(p.ws + WS_MOD); bf16_t* XN = (bf16_t*)(p.ws + WS_XN);
    const int gw = blockIdx.x * 8 + wave, NGW = gridDim.x * 8;
    for (int item = gw; item < M / 8; item += NGW) {
        const int m0 = item * 8; const float* mb = mod + batch_of(m0) * NMOD;
        f32x4 gs[4], sh[4];
#pragma unroll
        for (int j = 0; j < 4; ++j) { const f32x4 g = ((const f32x4*)p.g_pre_mix)[lane + 64 * j], s = ((const f32x4*)(mb + D))[lane + 64 * j];
            gs[j] = g * (1.0f + s); sh[j] = ((const f32x4*)mb)[lane + 64 * j]; }
        for (int r = 0; r < 8; ++r) { const int m = m0 + r; const f32x4* xr = (const f32x4*)xrow_ptr(p, m) + lane;
            f32x4 v[4]; float ss = 0.f;
#pragma unroll
            for (int j = 0; j < 4; ++j) { v[j] = xr[64 * j]; ss += (v[j][0] * v[j][0] + v[j][1] * v[j][1]) + (v[j][2] * v[j][2] + v[j][3] * v[j][3]); }
            const float rstd = rsqrtf(wave_sum(ss) * (1.0f / D) + RMS_EPS);
            u32x2* o8 = (u32x2*)(XN + (size_t)m * D) + lane;
#pragma unroll
            for (int j = 0; j < 4; ++j) { const f32x4 h = v[j] * rstd * gs[j] + sh[j]; u32x2 w; w.x = pk2(h[0], h[1]); w.y = pk2(h[2], h[3]); o8[64 * j] = w; }
        }
    }
}

constexpr int G_SP = 272, G_IMG = 64 * G_SP;
__device__ __forceinline__ void gmlp_item(const Params& p, int n, LAS unsigned char* lds, int wave, int lane) {
    const bf16_t* PROJ = (const bf16_t*)(p.ws + WS_PROJ); bf16_t* CAT = (bf16_t*)(p.ws + WS_CAT); const bf16_t* WSB = (const bf16_t*)(p.ws + WS_WSB);
    const int m0 = n * 128, g = wave >> 1, r32 = lane & 31, h = lane >> 5;
    {
        const int pos = (wave & 1) * 64 + lane;
        const bf16_t* vp = PROJ + (size_t)(m0 + pos) * NIN + GVOFF + g * 64;
        float v[64]; float s = 0.f;
#pragma unroll
        for (int c8 = 0; c8 < 8; ++c8) { const bf16x8 raw = *(const bf16x8*)(vp + 8 * c8);
#pragma unroll
            for (int e = 0; e < 8; ++e) { const float t = gelu_tanh(bf2f(raw[e])); v[8 * c8 + e] = t; s += t; } }
        const float mu = s * (1.0f / 64.0f); float q = 0.f;
#pragma unroll
        for (int c = 0; c < 64; ++c) { const float d = v[c] - mu; q += d * d; }
        const float rstd = rsqrtf(q * (1.0f / 64.0f) + LN_EPS);
        LAS unsigned char* img = lds + g * G_IMG + pos * 2;
#pragma unroll
        for (int c = 0; c < 64; c += 2) { const unsigned w = pk2((v[c] - mu) * rstd * p.g_gmlp[g * 64 + c], (v[c + 1] - mu) * rstd * p.g_gmlp[g * 64 + c + 1]);
            *(LAS unsigned short*)(img + c * G_SP) = (unsigned short)(w & 0xffffu); *(LAS unsigned short*)(img + (c + 1) * G_SP) = (unsigned short)(w >> 16); }
    }
    __syncthreads();
    {
        const int th = wave & 1;
        f32x16 acc[2][2];
#pragma unroll
        for (int a = 0; a < 2; ++a)
#pragma unroll
            for (int b = 0; b < 2; ++b)
#pragma unroll
                for (int i = 0; i < 16; ++i) acc[a][b][i] = 0.f;
        const bf16_t* wrow = WSB + (size_t)(g * 128 + 64 * th + r32) * 128 + 8 * h;
        const LAS unsigned char* brow = lds + g * G_IMG + r32 * G_SP + 16 * h;
#pragma unroll
        for (int ks = 0; ks < 8; ++ks) {
            bf16x8 a[2], b[2];
#pragma unroll
            for (int tb = 0; tb < 2; ++tb) a[tb] = *(const bf16x8*)(wrow + (size_t)(32 * tb) * 128 + 16 * ks);
#pragma unroll
            for (int cb = 0; cb < 2; ++cb) b[cb] = *(const LAS bf16x8*)(brow + (32 * cb) * G_SP + 32 * ks);
#pragma unroll
            for (int tb = 0; tb < 2; ++tb)
#pragma unroll
                for (int cb = 0; cb < 2; ++cb) acc[tb][cb] = MFMA32(a[tb], b[cb], acc[tb][cb]);
            if (ks & 1) asm volatile("" ::: "memory");
        }
#pragma unroll
        for (int tb = 0; tb < 2; ++tb)
#pragma unroll
            for (int i = 0; i < 16; ++i) { const int t = 64 * th + 32 * tb + crow(i, h); const float bias = p.b_s[g * 128 + t];
                const bf16_t* up = PROJ + (size_t)(m0 + t) * NIN + GUOFF + g * 64 + r32; bf16_t* op = CAT + (size_t)(m0 + t) * D + 768 + g * 64 + r32;
#pragma unroll
                for (int cb = 0; cb < 2; ++cb) { const float u = gelu_tanh(bf2f((short)up[32 * cb])); op[32 * cb] = (bf16_t)(pk2(u * (acc[tb][cb][i] + bias), 0.f) & 0xffffu); }
                if ((i & 3) == 3) asm volatile("" ::: "memory"); }
    }
    __syncthreads();
}

constexpr int V_SP = 144, V_BUF = 32 * V_SP;
__device__ __forceinline__ s16x4 vtr(const LAS unsigned char* q) { return __builtin_bit_cast(s16x4, __builtin_amdgcn_ds_read_tr16_b64_v4i16((LAS v4i16_t*)q)); }
__device__ __forceinline__ void attn_tile(const Params& p, int id, LAS unsigned char* vbuf, int lane) {
    const bf16_t* PROJ = (const bf16_t*)(p.ws + WS_PROJ); bf16_t* CAT = (bf16_t*)(p.ws + WS_CAT); float* LSE = (float*)(p.ws + WS_LSE);
    asm volatile("" : "+v"(lane));
    const int r32 = lane & 31, h = lane >> 5;
    const int t = id & 31, rest = id >> 5, hd = rest % 12, chunk = rest / 12;
    int seq_base, S, cs;
    if (chunk < 16) { seq_base = (chunk >> 2) * PSEQ; S = PSEQ; cs = (chunk & 3) * 1024; }
    else { const int c2 = chunk - 16; seq_base = MP + (c2 >> 1) * SSEQ; S = SSEQ; cs = (c2 & 1) * 1024; }
    const int dsh = 2 * (hd >> 2), dil = 1 << dsh, L = S >> dsh;
    const int r = t & (dil - 1), blk = t >> dsh;
    const int i0 = (cs >> dsh) + blk * 32;
    const float slope = exp2f(-8.0f * (float)(hd + 1) / 12.0f);
    const float c_s = 0.125f * LOG2E, c_b = slope * (float)dil * LOG2E;
    const bf16_t* base = PROJ + (size_t)(seq_base + r) * NIN + hd * 64;
    const size_t rstride = (size_t)dil * NIN;
    bf16x8 bq[4];
    { const bf16_t* qp = base + QOFF + (size_t)(i0 + r32) * rstride + 8 * h;
#pragma unroll
      for (int s = 0; s < 4; ++s) bq[s] = *(const bf16x8*)(qp + 16 * s); }
    f32x16 sc[5];
    bf16x8 ak[2][4];
    { int ki = i0 - 64 + r32; ki = ki < 0 ? 0 : ki; const bf16_t* kp = base + KOFF + (size_t)ki * rstride + 8 * h;
#pragma unroll
      for (int s = 0; s < 4; ++s) ak[0][s] = *(const bf16x8*)(kp + 16 * s); }
#pragma unroll
    for (int kb = 0; kb < 5; ++kb) {
        if (kb + 1 < 5) { int ki = i0 - 64 + (kb + 1) * 32 + r32; ki = ki < 0 ? 0 : (ki > L - 1 ? L - 1 : ki);
            const bf16_t* kp = base + KOFF + (size_t)ki * rstride + 8 * h;
#pragma unroll
            for (int s = 0; s < 4; ++s) ak[(kb + 1) & 1][s] = *(const bf16x8*)(kp + 16 * s); }
        f32x16 a;
#pragma unroll
        for (int i = 0; i < 16; ++i) a[i] = 0.f;
#pragma unroll
        for (int s = 0; s < 4; ++s) a = MFMA32(ak[kb & 1][s], bq[s], a);
        sc[kb] = a;
        asm volatile("" ::: "memory");
    }
    float mx = -1e30f;
    const float qoff = (float)(64 + r32 - 4 * h);
    const float lo = fmaxf(-64.0f, -(float)(i0 + r32)), hi = fminf(64.0f, (float)(L - 1 - i0 - r32));
#pragma unroll
    for (int kb = 0; kb < 5; ++kb)
#pragma unroll
        for (int i = 0; i < 16; ++i) { const float rel = (float)(kb * 32 + (i & 3) + 8 * (i >> 2)) - qoff;
            const bool valid = (rel >= lo) && (rel <= hi);
            float tv = sc[kb][i] * c_s - c_b * __builtin_fabsf(rel); tv = valid ? tv : -1e30f; sc[kb][i] = tv; mx = fmaxf(mx, tv); }
    mx = fmaxf(mx, __shfl_xor(mx, 32));
    float sum = 0.f;
#pragma unroll
    for (int kb = 0; kb < 5; ++kb)
#pragma unroll
        for (int i = 0; i < 16; ++i) { const float e = __builtin_amdgcn_exp2f(sc[kb][i] - mx); sum += e; sc[kb][i] = e; }
    sum += __shfl_xor(sum, 32);
    bf16x8 pb[5][2];
#pragma unroll
    for (int kb = 0; kb < 5; ++kb)
#pragma unroll
        for (int s = 0; s < 2; ++s) { u32x4 w; w.x = pk2(sc[kb][8 * s], sc[kb][8 * s + 1]); w.y = pk2(sc[kb][8 * s + 2], sc[kb][8 * s + 3]);
            w.z = pk2(sc[kb][8 * s + 4], sc[kb][8 * s + 5]); w.w = pk2(sc[kb][8 * s + 6], sc[kb][8 * s + 7]); pb[kb][s] = __builtin_bit_cast(bf16x8, w); }
    f32x16 o[2];
#pragma unroll
    for (int db = 0; db < 2; ++db)
#pragma unroll
        for (int i = 0; i < 16; ++i) o[db][i] = 0.f;
    const int i16 = lane & 15, tq = i16 >> 2, tp = i16 & 3, blk16 = (lane >> 4) & 1;
    const LAS unsigned char* trb = vbuf + (4 * h + tq) * V_SP + blk16 * 32 + 8 * tp;
#pragma unroll
    for (int kb = 0; kb < 5; ++kb) {
        bf16x8 vr[4];
#pragma unroll
        for (int i = 0; i < 4; ++i) { const int c = lane + 64 * i, row = c >> 3, c16 = c & 7; int ki = i0 - 64 + kb * 32 + row; ki = ki < 0 ? 0 : (ki > L - 1 ? L - 1 : ki);
            vr[i] = *(const bf16x8*)(base + VOFF + (size_t)ki * rstride + 8 * c16); }
        LDS_WAIT();
#pragma unroll
        for (int i = 0; i < 4; ++i) { const int c = lane + 64 * i, row = c >> 3, c16 = c & 7; *(LAS bf16x8*)(vbuf + row * V_SP + 16 * c16) = vr[i]; }
        LDS_WAIT();
#pragma unroll
        for (int s = 0; s < 2; ++s)
#pragma unroll
            for (int db = 0; db < 2; ++db) {
                const s16x4 lo = vtr(trb + (16 * s) * V_SP + 64 * db), hi = vtr(trb + (16 * s + 8) * V_SP + 64 * db);
                const bf16x8 va = __builtin_shufflevector(lo, hi, 0, 1, 2, 3, 4, 5, 6, 7);
                o[db] = MFMA32(va, pb[kb][s], o[db]);
            }
    }
    const float inv = __builtin_amdgcn_rcpf(sum);
    const int rowq = seq_base + (i0 + r32) * dil + r;
    bf16_t* op = CAT + (size_t)rowq * D + hd * 64 + 4 * h;
#pragma unroll
    for (int db = 0; db < 2; ++db)
#pragma unroll
        for (int g4 = 0; g4 < 4; ++g4) { u32x2 w; w.x = pk2(o[db][4 * g4] * inv, o[db][4 * g4 + 1] * inv); w.y = pk2(o[db][4 * g4 + 2] * inv, o[db][4 * g4 + 3] * inv);
            *(u32x2*)(op + 32 * db + 8 * g4) = w; }
    if (h == 0) LSE[(size_t)rowq * 12 + hd] = (mx + __log2f(sum)) * LN2;
}
__device__ __forceinline__ void phase3(const Params& p, LAS unsigned char* lds, int wave, int lane) {
    const int G = gridDim.x;
#ifndef NO_GMLP
    for (int n = blockIdx.x; n < M / 128; n += G) gmlp_item(p, n, lds, wave, lane);
#endif
    __syncthreads();
    LAS unsigned char* vbuf = lds + wave * V_BUF;
    constexpr int NTILES = (M / 32) * 12;
#ifndef NO_ATTN
    for (int g8 = blockIdx.x; g8 < NTILES / 8; g8 += G) attn_tile(p, g8 * 8 + wave, vbuf, lane);
#endif
}

__device__ __forceinline__ void phase4(const Params& p, int wave, int lane) {
    bf16_t* CAT = (bf16_t*)(p.ws + WS_CAT); const float* LSE = (const float*)(p.ws + WS_LSE);
    const int gw = blockIdx.x * 8 + wave, NGW = gridDim.x * 8;
    for (int m = gw; m < M; m += NGW) {
        const float* l = LSE + (size_t)m * 12;
        for (int c = lane; c < 96; c += 64) { const int hd = c >> 3, g = hd >> 2, j = hd & 3;
            const float l0 = l[j], l1 = l[4 + j], l2 = l[8 + j]; const float mxl = fmaxf(l0, fmaxf(l1, l2));
            const float e0 = __expf(l0 - mxl), e1 = __expf(l1 - mxl), e2 = __expf(l2 - mxl);
            const float w = (g == 0 ? e0 : (g == 1 ? e1 : e2)) / (e0 + e1 + e2);
            u32x4* q = (u32x4*)(CAT + (size_t)m * D) + c; u32x4 v = *q;
            v.x = pk2(bflo(v.x) * w, bfhi(v.x) * w); v.y = pk2(bflo(v.y) * w, bfhi(v.y) * w); v.z = pk2(bflo(v.z) * w, bfhi(v.z) * w); v.w = pk2(bflo(v.w) * w, bfhi(v.w) * w);
            *q = v; }
    }
}

__device__ __forceinline__ void phase6(const Params& p, int wave, int lane) {
    const float* mod = (const float*)(p.ws + WS_MOD); bf16_t* XN = (bf16_t*)(p.ws + WS_XN); const bf16_t* MIX = (const bf16_t*)(p.ws + WS_PROJ);
    const int gw = blockIdx.x * 8 + wave, NGW = gridDim.x * 8;
    for (int item = gw; item < M / 8; item += NGW) {
        const int m0 = item * 8; const float* mb = mod + batch_of(m0) * NMOD;
        f32x4 a1[4], gs[4], sh[4];
#pragma unroll
        for (int j = 0; j < 4; ++j) { const int o = lane + 64 * j;
            a1[j] = ((const f32x4*)(mb + 2 * D))[o] * ((const f32x4*)p.g_post_mix)[o];
            gs[j] = ((const f32x4*)p.g_pre_ffn)[o] * (1.0f + ((const f32x4*)(mb + 4 * D))[o]); sh[j] = ((const f32x4*)(mb + 3 * D))[o]; }
        for (int r = 0; r < 8; ++r) { const int m = m0 + r; const f32x4* xr = (const f32x4*)xrow_ptr(p, m) + lane; const u32x2* mr = (const u32x2*)(MIX + (size_t)m * D) + lane;
            f32x4 v[4], y[4]; float ss = 0.f;
#pragma unroll
            for (int j = 0; j < 4; ++j) { v[j] = xr[64 * j]; const u32x2 w = mr[64 * j]; y[j] = (f32x4){bflo(w.x), bfhi(w.x), bflo(w.y), bfhi(w.y)};
                ss += (y[j][0] * y[j][0] + y[j][1] * y[j][1]) + (y[j][2] * y[j][2] + y[j][3] * y[j][3]); }
            const float rstd = rsqrtf(wave_sum(ss) * (1.0f / D) + RMS_EPS);
            f32x4* orow = (f32x4*)(p.out + (size_t)m * D) + lane; float s2 = 0.f;
#pragma unroll
            for (int j = 0; j < 4; ++j) { v[j] = v[j] + a1[j] * (y[j] * rstd); orow[64 * j] = v[j]; s2 += (v[j][0] * v[j][0] + v[j][1] * v[j][1]) + (v[j][2] * v[j][2] + v[j][3] * v[j][3]); }
            const float rstd2 = rsqrtf(wave_sum(s2) * (1.0f / D) + RMS_EPS);
            u32x2* o8 = (u32x2*)(XN + (size_t)m * D) + lane;
#pragma unroll
            for (int j = 0; j < 4; ++j) { const f32x4 hh = v[j] * rstd2 * gs[j] + sh[j]; u32x2 w; w.x = pk2(hh[0], hh[1]); w.y = pk2(hh[2], hh[3]); o8[64 * j] = w; }
        }
    }
}
__device__ __forceinline__ void phase9(const Params& p, int wave, int lane) {
    const float* mod = (const float*)(p.ws + WS_MOD); const bf16_t* FB = (const bf16_t*)(p.ws + WS_CAT);
    const int gw = blockIdx.x * 8 + wave, NGW = gridDim.x * 8;
    for (int item = gw; item < M / 8; item += NGW) {
        const int m0 = item * 8; const float* mb = mod + batch_of(m0) * NMOD;
        f32x4 a2[4];
#pragma unroll
        for (int j = 0; j < 4; ++j) { const int o = lane + 64 * j; a2[j] = ((const f32x4*)(mb + 5 * D))[o] * ((const f32x4*)p.g_post_ffn)[o]; }
        for (int r = 0; r < 8; ++r) { const int m = m0 + r; f32x4* orow = (f32x4*)(p.out + (size_t)m * D) + lane; const u32x2* fr = (const u32x2*)(FB + (size_t)m * D) + lane;
            f32x4 v[4], y[4]; float ss = 0.f;
#pragma unroll
            for (int j = 0; j < 4; ++j) { v[j] = orow[64 * j]; const u32x2 w = fr[64 * j]; y[j] = (f32x4){bflo(w.x), bfhi(w.x), bflo(w.y), bfhi(w.y)};
                ss += (y[j][0] * y[j][0] + y[j][1] * y[j][1]) + (y[j][2] * y[j][2] + y[j][3] * y[j][3]); }
            const float rstd = rsqrtf(wave_sum(ss) * (1.0f / D) + RMS_EPS);
#pragma unroll
            for (int j = 0; j < 4; ++j) orow[64 * j] = v[j] + a2[j] * (y[j] * rstd);
        }
    }
}

#define XB_TMO      128
#define XB_XCNT(j)  (256  + 64 * (j))
#define XB_XSUB(j)  (1280 + 64 * (j))
#define XB_XGEN(j)  (2304 + 64 * (j))
#define XB_TOP      3328
#define XB_TOPGEN   3392
#define XCD_BAR_WORDS 3456
#define XB_SPIN_CAP (1u << 18)

__device__ __forceinline__ unsigned xb_ld(unsigned* p)              { return __hip_atomic_load(p, __ATOMIC_RELAXED, __HIP_MEMORY_SCOPE_AGENT); }
__device__ __forceinline__ unsigned xb_add(unsigned* p, unsigned v) { return __hip_atomic_fetch_add(p, v, __ATOMIC_RELAXED, __HIP_MEMORY_SCOPE_AGENT); }
__device__ __forceinline__ unsigned xb_xcc_id() { return (unsigned)__builtin_amdgcn_s_getreg((3 << 11) | 20) & 0xFu; }
#define XB_SPIN(cond, bar) do { unsigned _sp = 0; while (cond) { __builtin_amdgcn_s_sleep(1); \
    if ((++_sp & 255u) == 0u) { if (xb_ld(&(bar)[XB_TMO])) break; if (_sp > XB_SPIN_CAP) { atomicAdd(&(bar)[XB_TMO], 1u); break; } } } } while (0)

struct XcdBarrier {
    unsigned* bar; unsigned x;
    volatile LAS unsigned* st;
};

__device__ __forceinline__ XcdBarrier xcd_barrier_post(unsigned* bar, volatile LAS unsigned* st) {
    XcdBarrier b; b.bar = bar; b.x = xb_xcc_id(); b.st = st;
    if (threadIdx.x == 0) (void)xb_add(&bar[XB_XCNT(b.x)], 1u);
    return b;
}
__device__ __forceinline__ void xcd_barrier_complete(unsigned* bar, unsigned x, unsigned& nloc, unsigned& nx) {
    const unsigned G = gridDim.x * gridDim.y * gridDim.z;
    unsigned sum, cnt, mine, sp = 0u;
    for (;;) {
        sum = 0u; cnt = 0u; mine = 0u;
#pragma unroll
        for (unsigned j = 0; j < 16; ++j) { const unsigned c = xb_ld(&bar[XB_XCNT(j)]); sum += c; cnt += (c > 0u) ? 1u : 0u; mine = (j == x) ? c : mine; }
        if (sum == G) break;
        __builtin_amdgcn_s_sleep(1);
        if ((++sp & 255u) == 0u) { if (xb_ld(&bar[XB_TMO])) break; if (sp > XB_SPIN_CAP) { atomicAdd(&bar[XB_TMO], 1u); break; } }
    }
    nloc = mine > 0u ? mine : 1u; nx = cnt > 0u ? cnt : 1u;
}

__device__ __forceinline__ void xcd_barrier(const XcdBarrier& b) {
    asm volatile("s_waitcnt vmcnt(0)" ::: "memory");
    __syncthreads();
    if (threadIdx.x == 0) {
        unsigned* bar = b.bar;
        __builtin_amdgcn_s_waitcnt(0);
        unsigned nloc = b.st[0], nx = b.st[1];
        if (nloc == 0u) { xcd_barrier_complete(bar, b.x, nloc, nx); b.st[0] = nloc; b.st[1] = nx; }
        const unsigned old = xb_add(&bar[XB_XSUB(b.x)], 1u);
        const unsigned gen = old / nloc;
        if (old + 1u == (gen + 1u) * nloc) {
            __builtin_amdgcn_fence(__ATOMIC_RELEASE, "agent");
            asm volatile("s_waitcnt vmcnt(0)" ::: "memory");
            const unsigned og = xb_add(&bar[XB_TOP], 1u);
            const unsigned tg = og / nx;
            if (og + 1u == (tg + 1u) * nx) xb_add(&bar[XB_TOPGEN], 1u);
            else XB_SPIN(xb_ld(&bar[XB_TOPGEN]) == tg, bar);
            __builtin_amdgcn_fence(__ATOMIC_ACQUIRE, "agent");
            xb_add(&bar[XB_XGEN(b.x)], 1u);
            asm volatile("s_waitcnt vmcnt(0)" ::: "memory");
        } else {
            XB_SPIN(xb_ld(&bar[XB_XGEN(b.x)]) == gen, bar);
            __builtin_amdgcn_fence(__ATOMIC_ACQUIRE, "agent");
            asm volatile("s_waitcnt vmcnt(0)" ::: "memory");
        }
    }
    __syncthreads();
}

__global__ void __launch_bounds__(512, 2) fwd_megakernel(Params p) {
    extern __shared__ __attribute__((aligned(16))) unsigned char lds_raw[];
    LAS unsigned char* lds = (LAS unsigned char*)lds_raw;
    cg::grid_group grid = cg::this_grid();
    const int G = gridDim.x;
#define TID_SETUP() int tid = threadIdx.x; asm volatile("" : "+v"(tid)); const int lane = tid & 63, wave = __builtin_amdgcn_readfirstlane(tid >> 6); (void)lane; (void)wave
    unsigned char* ws = p.ws;
    if (threadIdx.x < 2) ((volatile LAS unsigned*)(lds + 131072))[threadIdx.x] = 0u;
    if (blockIdx.x == 0) for (int i = threadIdx.x; i < XCD_BAR_WORDS; i += 512) __hip_atomic_store((unsigned*)(ws + WS_BAR) + i, 0u, __ATOMIC_RELAXED, __HIP_MEMORY_SCOPE_AGENT);
    __syncthreads();
#ifdef NO_ALLGEMM
#define IN(k) ((k) != 2 && (k) != 5 && (k) != 7 && (k) != 8 && p.ph_lo <= (k) && (k) < p.ph_hi)
#else
#define IN(k) (p.ph_lo <= (k) && (k) < p.ph_hi)
#endif
#define SEAM(k) do { if (IN(k) && IN((k) + 1)) xcd_barrier(bar); } while (0)
#define REP(k) for (int rp_ = 0, nr_ = (p.rep_phase == (k) ? p.rep_count : 1); rp_ < nr_; ++rp_, (rp_ < nr_ ? xcd_barrier(bar) : (void)0))
#ifndef NO_P0
    if (IN(0)) { TID_SETUP(); phase0(p, lds, tid, wave, lane); }
#endif
    grid.sync();
    XcdBarrier bar = xcd_barrier_post((unsigned*)(ws + WS_BAR), (volatile LAS unsigned*)(lds + 131072));
#ifndef NO_P1
#ifdef PROBE_SYNCS
    for (int i_ = 0; i_ < p.rep_count; ++i_) xcd_barrier(bar);
#endif
    REP(1) if (IN(1)) { TID_SETUP(); phase1(p, wave, lane); }
#endif
    SEAM(1);
#ifndef NO_GEMM
    REP(2) if (IN(2)) {
        pg8::Gemm g{(const bf16_t*)(ws + WS_XN), (const bf16_t*)(ws + WS_WIN), M, NIN, D}; pg8::StaticOrder S; S.init(M, NIN, G, (int)blockIdx.x);
        pg8::EpiStore E{(bf16_t*)(ws + WS_PROJ), NIN};
        pg8::gemm_phase<pg8::EpiStore, pg8::StaticOrder, true, true>(lds, g, S, E);
    }
#endif
    SEAM(2);
#ifndef NO_P3
    REP(3) if (IN(3)) { TID_SETUP(); phase3(p, lds, wave, lane); }
#endif
    SEAM(3);
#ifndef NO_P4
    REP(4) if (IN(4)) { TID_SETUP(); phase4(p, wave, lane); }
#endif
    SEAM(4);
    REP(5) if (IN(5)) {
        pg8::Gemm g{(const bf16_t*)(ws + WS_CAT), (const bf16_t*)(ws + WS_WOUT), M, D, D}; pg8::StaticOrder S; S.init(M, D, G, (int)blockIdx.x);
        pg8::EpiStore E{(bf16_t*)(ws + WS_PROJ), D};
        pg8::gemm_phase<pg8::EpiStore, pg8::StaticOrder, true, true>(lds, g, S, E);
    }
    SEAM(5);
#ifndef NO_P6
    REP(6) if (IN(6)) { TID_SETUP(); phase6(p, wave, lane); }
#endif
    SEAM(6);
    REP(7) if (IN(7)) {
        pg8::Gemm g{(const bf16_t*)(ws + WS_XN), (const bf16_t*)(ws + WS_WGU), M, 2 * NFF, D}; pg8::StaticOrder S; S.init(M, 2 * NFF, G, (int)blockIdx.x);
        pg8::EpiSwiGLU E{(bf16_t*)(ws + WS_PROJ), NFF};
        pg8::gemm_phase<pg8::EpiSwiGLU, pg8::StaticOrder, true, true>(lds, g, S, E);
    }
    SEAM(7);
    REP(8) if (IN(8)) {
        pg8::Gemm g{(const bf16_t*)(ws + WS_PROJ), (const bf16_t*)(ws + WS_WDN), M, D, NFF}; pg8::StaticOrder S; S.init(M, D, G, (int)blockIdx.x);
        pg8::EpiStore E{(bf16_t*)(ws + WS_CAT), D};
        pg8::gemm_phase<pg8::EpiStore, pg8::StaticOrder, true, true>(lds, g, S, E);
    }
    SEAM(8);
#ifndef NO_P9
    REP(9) if (IN(9)) { TID_SETUP(); phase9(p, wave, lane); }
#endif
#undef IN
#undef SEAM
}

#ifndef MK_N_LAUNCHES
#define MK_N_LAUNCHES 1
#endif
extern "C" void kernel_launch(void* const* d_in, const int* in_sizes, int n_in, void* d_out, int out_size, void* d_ws, size_t ws_size, hipStream_t stream) {
    static int grid = 0;
    if (grid == 0) {
        if (n_in != 17 || out_size != M * D || ws_size < WS_END) { fprintf(stderr, "kernel_launch: unexpected sizes (n_in %d, out %d, ws %zu)\n", n_in, out_size, ws_size); grid = -1; return; }
        int dev = 0, cus = 0, per_cu = 0;
        if (hipGetDevice(&dev) != hipSuccess || hipDeviceGetAttribute(&cus, hipDeviceAttributeMultiprocessorCount, dev) != hipSuccess) { grid = -1; return; }
        if (hipFuncSetAttribute((const void*)fwd_megakernel, hipFuncAttributeMaxDynamicSharedMemorySize, LDS_BYTES) != hipSuccess) { fprintf(stderr, "kernel_launch: hipFuncSetAttribute failed\n"); grid = -1; return; }
        if (hipOccupancyMaxActiveBlocksPerMultiprocessor(&per_cu, (const void*)fwd_megakernel, 512, LDS_BYTES) != hipSuccess || per_cu < 1) { fprintf(stderr, "kernel_launch: occupancy query reports %d\n", per_cu); grid = -1; return; }
        grid = cus;
    }
    if (grid < 0) return;
    Params p{};
    p.x_prompt = (const float*)d_in[0]; p.x_sample = (const float*)d_in[1]; p.c_prompt = (const float*)d_in[2]; p.c_sample = (const float*)d_in[3];
    p.w_ada = (const float*)d_in[4]; p.b_ada = (const float*)d_in[5]; p.g_pre_mix = (const float*)d_in[6]; p.w_in = (const float*)d_in[7];
    p.w_s = (const float*)d_in[8]; p.b_s = (const float*)d_in[9]; p.g_gmlp = (const float*)d_in[10]; p.w_out = (const float*)d_in[11];
    p.g_post_mix = (const float*)d_in[12]; p.g_pre_ffn = (const float*)d_in[13]; p.w_gu = (const float*)d_in[14]; p.w_down = (const float*)d_in[15]; p.g_post_ffn = (const float*)d_in[16];
    p.out = (float*)d_out; p.ws = (unsigned char*)d_ws;
#if MK_N_LAUNCHES == 1
    p.ph_lo = 0; p.ph_hi = 10;
#ifdef PROBE_PHASE
    p.rep_phase = PROBE_PHASE; p.rep_count = PROBE_COUNT;
#else
    p.rep_phase = -1; p.rep_count = 1;
#endif
    void* args[] = {&p};
    const hipError_t e = hipLaunchCooperativeKernel((const void*)fwd_megakernel, dim3(grid), dim3(512), args, LDS_BYTES, stream);
    if (e != hipSuccess) fprintf(stderr, "kernel_launch: cooperative launch failed: %s (grid %d)\n", hipGetErrorString(e), grid);
#else
    for (int k = 0; k < 10; ++k) { p.ph_lo = k; p.ph_hi = k + 1; hipLaunchKernelGGL(fwd_megakernel, dim3(grid), dim3(512), LDS_BYTES, stream, p); }
#endif
}
```
